# Optimizing an MI355X kernel written in HIP

```python
import numpy as np
import jax
import jax.numpy as jnp
from jax import lax

D_MODEL = 1024
BATCH = 4
SEQ = 8192
DEPTH = 4

N_MIXERS = 2
RMS_EPS = 1e-6
ROPE_THETA = 10000.0
NEG_INF = -1e30
N_NSA_LAYERS = (DEPTH + 1) // 2
N_MLA_LAYERS = DEPTH // 2

NSA_HEADS = 16
NSA_HEAD_DIM = D_MODEL // NSA_HEADS
NSA_KV_GROUPS = 4
NSA_HEADS_PER_GROUP = NSA_HEADS // NSA_KV_GROUPS
CMP_LEN = 32
CMP_STRIDE = 16
CMP_CHUNKS = CMP_LEN // CMP_STRIDE
CMP_HIDDEN = 128
SEL_LEN = 64
SEL_RATIO = SEL_LEN // CMP_STRIDE
SEL_TOPK = 16
SEL_FORCE = 1e4
WINDOW = 512
NSA_Q_BLOCK = 64
NSA_Q_DIM = NSA_HEADS * NSA_HEAD_DIM
NSA_KV_DIM = NSA_KV_GROUPS * NSA_HEAD_DIM
NSA_IN_DIM = NSA_Q_DIM + 6 * NSA_KV_DIM + 3 * NSA_HEADS

MLA_HEADS = 8
MLA_NOPE_DIM = 128
MLA_ROPE_DIM = 64
MLA_V_DIM = 128
MLA_Q_LORA = 256
MLA_KV_LORA = 256
MLA_IN_DIM = MLA_Q_LORA + MLA_KV_LORA + MLA_ROPE_DIM
ATTN_Q_BLOCK = 128

MOE_GROUPS = 8
MOE_EXPERTS_PER_GROUP = 8
MOE_EXPERTS = MOE_GROUPS * MOE_EXPERTS_PER_GROUP
MOE_TOP_K = 2
MOE_FF = 256
MOE_BLOCK = 128

kernel_name = 'hybrid_nsa_mla_hier_moe'


def rmsnorm(x, g):
    x32 = x.astype(jnp.float32)
    y = x32 * lax.rsqrt(jnp.mean(x32 * x32, axis=-1, keepdims=True) + RMS_EPS)
    return (y * g.astype(jnp.float32)).astype(x.dtype)


def rope_tables(seq, dim):
    inv = 1.0 / (ROPE_THETA ** (jnp.arange(0, dim, 2, dtype=jnp.float32) / dim))
    ang = jnp.arange(seq, dtype=jnp.float32)[:, None] * inv[None, :]
    return jnp.cos(ang), jnp.sin(ang)


def apply_rope(x, cos, sin):
    half = x.shape[-1] // 2
    x32 = x.astype(jnp.float32)
    x1, x2 = x32[..., :half], x32[..., half:]
    c, s = cos[:, None, :], sin[:, None, :]
    return jnp.concatenate([x1 * c - x2 * s, x2 * c + x1 * s], axis=-1).astype(x.dtype)


def masked_softmax(s, mask):
    s = jnp.where(mask, s.astype(jnp.float32), NEG_INF)
    m = jnp.max(s, axis=-1, keepdims=True)
    e = jnp.where(mask, jnp.exp(s - m), 0.0)
    return e / jnp.maximum(jnp.sum(e, axis=-1, keepdims=True), 1e-30)


def sel_overlap_weights():
    offs = np.arange(-(CMP_CHUNKS - 1), SEL_RATIO)
    lo = np.maximum(offs * CMP_STRIDE, 0)
    hi = np.minimum(offs * CMP_STRIDE + CMP_LEN - 1, SEL_LEN - 1)
    return offs, ((hi - lo + 1) / CMP_STRIDE).astype(np.float32)


def nsa_mixer(h, w_in, cmp_pos, cmp_w1, cmp_w2, q_norm, k_norm, w_out, cos, sin):
    B, S, _ = h.shape
    H, G, R, Dh, QB = NSA_HEADS, NSA_KV_GROUPS, NSA_HEADS_PER_GROUP, NSA_HEAD_DIM, NSA_Q_BLOCK
    scale = Dh ** -0.5
    splits = [int(v) for v in np.cumsum([NSA_Q_DIM] + [NSA_KV_DIM] * 6)]
    q, k_c, v_c, k_s, v_s, k_w, v_w, gate_logits = jnp.split(h @ w_in, splits, axis=-1)
    kv = lambda t: t.reshape(B, S, G, Dh)
    q = rmsnorm(q.reshape(B, S, H, Dh), q_norm)
    q_rot = apply_rope(q, cos, sin)

    n_chunks = S // CMP_STRIDE
    n_cmp = n_chunks - CMP_CHUNKS + 1

    def compress(t, pos, w1, w2):
        chunks = t.reshape(B, n_chunks, CMP_STRIDE, G, Dh)
        blocks = jnp.concatenate([chunks[:, i:i + n_cmp] for i in range(CMP_CHUNKS)], axis=2)
        blocks = blocks + pos[None, None, :, None, :]
        flat = blocks.transpose(0, 1, 3, 2, 4).reshape(B, n_cmp, G, CMP_LEN * Dh)
        return jax.nn.gelu(flat @ w1) @ w2

    k_cmp = rmsnorm(compress(kv(k_c), cmp_pos[0], cmp_w1[0], cmp_w2[0]), k_norm[0])
    v_cmp = compress(kv(v_c), cmp_pos[1], cmp_w1[1], cmp_w2[1])
    cmp_end = jnp.arange(n_cmp) * CMP_STRIDE + CMP_LEN - 1

    n_sel = S // SEL_LEN
    sel_k = min(SEL_TOPK, n_sel)
    to_blocks = lambda t: t.reshape(B, n_sel, SEL_LEN, G, Dh).transpose(0, 3, 1, 2, 4)
    k_sel_b = to_blocks(apply_rope(rmsnorm(kv(k_s), k_norm[1]), cos, sin))
    v_sel_b = to_blocks(kv(v_s))
    offs, ow = sel_overlap_weights()
    imp_idx = jnp.asarray(SEL_RATIO * np.arange(n_sel)[:, None] + offs[None, :] + (CMP_CHUNKS - 1))
    imp_w = jnp.asarray(ow)
    back_pad = SEL_RATIO * n_sel - n_cmp
    sel_j = jnp.arange(n_sel)
    b_idx = jnp.arange(B)[:, None, None, None]
    g_idx = jnp.arange(G)[None, :, None, None]

    k_win = apply_rope(rmsnorm(kv(k_w), k_norm[2]), cos, sin)
    pad = ((0, 0), (WINDOW, 0), (0, 0), (0, 0))
    k_win_p, v_win_p = jnp.pad(k_win, pad), jnp.pad(kv(v_w), pad)

    gates = jax.nn.sigmoid(gate_logits.astype(jnp.float32)).reshape(B, S, 3, H).astype(h.dtype)
    nqb = S // QB
    qsplit = lambda t: t.reshape((B, nqb, QB) + t.shape[2:]).swapaxes(0, 1)

    def block(args):
        q_b, qr_b, g_b, bi = args
        t = bi * QB + jnp.arange(QB)
        q_g = q_b.reshape(B, QB, G, R, Dh)
        qr_g = qr_b.reshape(B, QB, G, R, Dh)
        s_c = jnp.einsum('bqgrd,bngd->bgrqn', q_g, k_cmp) * scale
        p_c = masked_softmax(s_c, cmp_end[None, :] <= t[:, None])
        o_c = jnp.einsum('bgrqn,bngd->bqgrd', p_c.astype(v_cmp.dtype), v_cmp)
        imp = jnp.pad(p_c.sum(axis=2), ((0, 0), (0, 0), (0, 0), (CMP_CHUNKS - 1, back_pad)))
        imp = imp[..., imp_idx] @ imp_w
        cur = t // SEL_LEN
        valid = sel_j[None, :] * SEL_LEN <= t[:, None]
        forced = (sel_j[None, :] == 0) | (sel_j[None, :] == cur[:, None]) | (sel_j[None, :] == cur[:, None] - 1)
        score = jnp.where(forced, SEL_FORCE, jnp.where(valid, imp, -1.0))
        _, sel = lax.top_k(score, sel_k)
        k_g = k_sel_b[b_idx, g_idx, sel]
        v_g = v_sel_b[b_idx, g_idx, sel].reshape(B, G, QB, sel_k * SEL_LEN, Dh)
        k_pos = sel[..., None] * SEL_LEN + jnp.arange(SEL_LEN)
        s_s = jnp.einsum('bqgrd,bgqkld->bgrqkl', qr_g, k_g) * scale
        s_mask = (k_pos <= t[None, None, :, None, None]).reshape(B, G, 1, QB, sel_k * SEL_LEN)
        p_s = masked_softmax(s_s.reshape(B, G, R, QB, sel_k * SEL_LEN), s_mask)
        o_s = jnp.einsum('bgrqk,bgqkd->bqgrd', p_s.astype(v_g.dtype), v_g)
        k_wb = lax.dynamic_slice_in_dim(k_win_p, bi * QB, QB + WINDOW, axis=1)
        v_wb = lax.dynamic_slice_in_dim(v_win_p, bi * QB, QB + WINDOW, axis=1)
        kp = bi * QB - WINDOW + jnp.arange(QB + WINDOW)
        w_mask = (kp[None, :] <= t[:, None]) & (kp[None, :] > t[:, None] - WINDOW) & (kp[None, :] >= 0)
        s_w = jnp.einsum('bqgrd,bkgd->bgrqk', qr_g, k_wb) * scale
        p_w = masked_softmax(s_w, w_mask)
        o_w = jnp.einsum('bgrqk,bkgd->bqgrd', p_w.astype(v_wb.dtype), v_wb)
        return (g_b[:, :, 0, :, None] * o_c.reshape(B, QB, H, Dh)
                + g_b[:, :, 1, :, None] * o_s.reshape(B, QB, H, Dh)
                + g_b[:, :, 2, :, None] * o_w.reshape(B, QB, H, Dh))

    o = lax.map(block, (qsplit(q), qsplit(q_rot), qsplit(gates), jnp.arange(nqb)))
    return o.swapaxes(0, 1).reshape(B, S, NSA_Q_DIM) @ w_out


def mla_mixer(h, w_in, q_lat_norm, kv_lat_norm, w_uq, w_ukv, q_nope_norm, q_rope_norm,
              k_nope_norm, k_rope_norm, w_out, cos, sin):
    B, S, _ = h.shape
    H = MLA_HEADS
    c_q, c_kv, k_r = jnp.split(h @ w_in, [MLA_Q_LORA, MLA_Q_LORA + MLA_KV_LORA], axis=-1)
    q = (rmsnorm(c_q, q_lat_norm) @ w_uq).reshape(B, S, H, MLA_NOPE_DIM + MLA_ROPE_DIM)
    kvu = (rmsnorm(c_kv, kv_lat_norm) @ w_ukv).reshape(B, S, H, MLA_NOPE_DIM + MLA_V_DIM)
    q_nope = rmsnorm(q[..., :MLA_NOPE_DIM], q_nope_norm)
    q_rope = apply_rope(rmsnorm(q[..., MLA_NOPE_DIM:], q_rope_norm), cos, sin)
    k_nope = rmsnorm(kvu[..., :MLA_NOPE_DIM], k_nope_norm)
    v = kvu[..., MLA_NOPE_DIM:]
    k_rope = apply_rope(rmsnorm(k_r.reshape(B, S, 1, MLA_ROPE_DIM), k_rope_norm), cos, sin)[:, :, 0]
    scale = (MLA_NOPE_DIM + MLA_ROPE_DIM) ** -0.5
    outs = []
    for start in range(0, S, ATTN_Q_BLOCK):
        end = start + ATTN_Q_BLOCK
        s = (jnp.einsum('bqhd,bkhd->bhqk', q_nope[:, start:end], k_nope[:, :end])
             + jnp.einsum('bqhd,bkd->bhqk', q_rope[:, start:end], k_rope[:, :end])) * scale
        mask = jnp.arange(end)[None, :] <= jnp.arange(start, end)[:, None]
        p = masked_softmax(s, mask)
        outs.append(jnp.einsum('bhqk,bkhd->bqhd', p.astype(v.dtype), v[:, :end]))
    o = jnp.concatenate(outs, axis=1).reshape(B, S, H * MLA_V_DIM)
    return o @ w_out


def hier_moe(x2, w_group, b_group, w_expert, b_expert, w_gate, w_up, w_down):
    T, D = x2.shape
    g_prob = jax.nn.softmax((x2 @ w_group + b_group).astype(jnp.float32), axis=-1)
    grp = jnp.argmax(g_prob, axis=-1)
    g_w = jnp.take_along_axis(g_prob, grp[:, None], axis=-1)
    e_logits = (x2 @ w_expert + b_expert).astype(jnp.float32).reshape(T, MOE_GROUPS, MOE_EXPERTS_PER_GROUP)
    e_logits = jnp.take_along_axis(e_logits, grp[:, None, None], axis=1)[:, 0]
    top_p, top_i = lax.top_k(jax.nn.softmax(e_logits, axis=-1), MOE_TOP_K)
    weights = (g_w * top_p / jnp.sum(top_p, axis=-1, keepdims=True)).astype(x2.dtype)
    expert_id = grp[:, None] * MOE_EXPERTS_PER_GROUP + top_i
    n_assign = T * MOE_TOP_K
    flat_e = expert_id.reshape(n_assign)
    flat_tok = jnp.arange(n_assign, dtype=jnp.int32) // MOE_TOP_K
    order = jnp.argsort(flat_e)
    sorted_e = flat_e[order]
    counts = jnp.bincount(flat_e, length=MOE_EXPERTS)
    starts = jnp.cumsum(counts) - counts
    padded = (counts + MOE_BLOCK - 1) // MOE_BLOCK * MOE_BLOCK
    pad_ends = jnp.cumsum(padded)
    pad_starts = pad_ends - padded
    dest = pad_starts[sorted_e] + jnp.arange(n_assign) - starts[sorted_e]
    n_blocks = -(-n_assign // MOE_BLOCK) + MOE_EXPERTS
    n_slots = n_blocks * MOE_BLOCK
    slot_tok = jnp.full((n_slots,), T, jnp.int32).at[dest].set(flat_tok[order])
    slot_w = jnp.zeros((n_slots,), x2.dtype).at[dest].set(weights.reshape(n_assign)[order])
    block_e = jnp.minimum(jnp.searchsorted(pad_ends, jnp.arange(n_blocks) * MOE_BLOCK, side='right'),
                          MOE_EXPERTS - 1)
    x_pad = jnp.concatenate([x2, jnp.zeros((1, D), x2.dtype)], axis=0)
    xs = x_pad[slot_tok].reshape(n_blocks, MOE_BLOCK, D)

    def expert_block(args):
        xb, e = args
        return (jax.nn.silu(xb @ w_gate[e]) * (xb @ w_up[e])) @ w_down[e]

    ys = lax.map(expert_block, (xs, block_e)).reshape(n_slots, D) * slot_w[:, None]
    return jnp.zeros((T + 1, D), ys.dtype).at[slot_tok].add(ys)[:T]


def setup_inputs(seed: int = 0) -> dict:
    key = jax.random.key(seed)
    ks = iter(jax.random.split(key, 32))

    def nrm(shape, scale):
        return jax.random.normal(next(ks), shape, jnp.float32) * scale

    def gain(shape):
        return 1.0 + 0.1 * nrm(shape, 1.0)

    LA, LB, L = N_NSA_LAYERS, N_MLA_LAYERS, DEPTH
    return {
        'x': nrm((BATCH, SEQ, D_MODEL), 1.0),
        'norm_mix': gain((L, D_MODEL)),
        'norm_ffn': gain((L, D_MODEL)),
        'nsa_w_in': nrm((LA, D_MODEL, NSA_IN_DIM), D_MODEL ** -0.5),
        'nsa_cmp_pos': nrm((LA, 2, CMP_LEN, NSA_HEAD_DIM), 0.1),
        'nsa_cmp_w1': nrm((LA, 2, CMP_LEN * NSA_HEAD_DIM, CMP_HIDDEN), (CMP_LEN * NSA_HEAD_DIM) ** -0.5),
        'nsa_cmp_w2': nrm((LA, 2, CMP_HIDDEN, NSA_HEAD_DIM), CMP_HIDDEN ** -0.5),
        'nsa_q_norm': gain((LA, NSA_HEAD_DIM)),
        'nsa_k_norm': gain((LA, 3, NSA_HEAD_DIM)),
        'nsa_w_out': nrm((LA, NSA_Q_DIM, D_MODEL), NSA_Q_DIM ** -0.5),
        'mla_w_in': nrm((LB, D_MODEL, MLA_IN_DIM), D_MODEL ** -0.5),
        'mla_q_lat_norm': gain((LB, MLA_Q_LORA)),
        'mla_kv_lat_norm': gain((LB, MLA_KV_LORA)),
        'mla_w_uq': nrm((LB, MLA_Q_LORA, MLA_HEADS * (MLA_NOPE_DIM + MLA_ROPE_DIM)), MLA_Q_LORA ** -0.5),
        'mla_w_ukv': nrm((LB, MLA_KV_LORA, MLA_HEADS * (MLA_NOPE_DIM + MLA_V_DIM)), MLA_KV_LORA ** -0.5),
        'mla_q_nope_norm': gain((LB, MLA_NOPE_DIM)),
        'mla_q_rope_norm': gain((LB, MLA_ROPE_DIM)),
        'mla_k_nope_norm': gain((LB, MLA_NOPE_DIM)),
        'mla_k_rope_norm': gain((LB, MLA_ROPE_DIM)),
        'mla_w_out': nrm((LB, MLA_HEADS * MLA_V_DIM, D_MODEL), (MLA_HEADS * MLA_V_DIM) ** -0.5),
        'moe_w_group': nrm((L, D_MODEL, MOE_GROUPS), D_MODEL ** -0.5),
        'moe_b_group': nrm((L, MOE_GROUPS), 0.01),
        'moe_w_expert': nrm((L, D_MODEL, MOE_EXPERTS), D_MODEL ** -0.5),
        'moe_b_expert': nrm((L, MOE_EXPERTS), 0.01),
        'moe_w_gate': nrm((L, MOE_EXPERTS, D_MODEL, MOE_FF), D_MODEL ** -0.5),
        'moe_w_up': nrm((L, MOE_EXPERTS, D_MODEL, MOE_FF), D_MODEL ** -0.5),
        'moe_w_down': nrm((L, MOE_EXPERTS, MOE_FF, D_MODEL), MOE_FF ** -0.5),
    }


def reference(x, norm_mix, norm_ffn, nsa_w_in, nsa_cmp_pos, nsa_cmp_w1, nsa_cmp_w2, nsa_q_norm,
              nsa_k_norm, nsa_w_out, mla_w_in, mla_q_lat_norm, mla_kv_lat_norm, mla_w_uq, mla_w_ukv,
              mla_q_nope_norm, mla_q_rope_norm, mla_k_nope_norm, mla_k_rope_norm, mla_w_out,
              moe_w_group, moe_b_group, moe_w_expert, moe_b_expert, moe_w_gate, moe_w_up, moe_w_down):
    B, S, D = x.shape
    cos_a, sin_a = rope_tables(S, NSA_HEAD_DIM)
    cos_b, sin_b = rope_tables(S, MLA_ROPE_DIM)
    for i in range(DEPTH):
        j = i // N_MIXERS
        h = rmsnorm(x, norm_mix[i])
        if i % N_MIXERS == 0:
            mix = nsa_mixer(h, nsa_w_in[j], nsa_cmp_pos[j], nsa_cmp_w1[j], nsa_cmp_w2[j],
                            nsa_q_norm[j], nsa_k_norm[j], nsa_w_out[j], cos_a, sin_a)
        else:
            mix = mla_mixer(h, mla_w_in[j], mla_q_lat_norm[j], mla_kv_lat_norm[j], mla_w_uq[j],
                            mla_w_ukv[j], mla_q_nope_norm[j], mla_q_rope_norm[j], mla_k_nope_norm[j],
                            mla_k_rope_norm[j], mla_w_out[j], cos_b, sin_b)
        x = x + mix
        h = rmsnorm(x, norm_ffn[i]).reshape(B * S, D)
        x = x + hier_moe(h, moe_w_group[i], moe_b_group[i], moe_w_expert[i], moe_b_expert[i],
                         moe_w_gate[i], moe_w_up[i], moe_w_down[i]).reshape(B, S, D)
    return x
```

```cpp
#include <hip/hip_runtime.h>
#include <stdint.h>
#include <stdio.h>

#define DI __device__ __forceinline__
#define GAS __attribute__((address_space(1)))
#define LAS __attribute__((address_space(3)))
typedef unsigned short bf16_t;
typedef short bf16x8 __attribute__((ext_vector_type(8)));
typedef short s16x4 __attribute__((ext_vector_type(4)));
typedef short v4i16_t __attribute__((ext_vector_type(4)));
typedef float f32x2 __attribute__((ext_vector_type(2)));
typedef float f32x4 __attribute__((ext_vector_type(4)));
typedef float f32x16 __attribute__((ext_vector_type(16)));
typedef unsigned u32x2 __attribute__((ext_vector_type(2)));
typedef unsigned u32x4 __attribute__((ext_vector_type(4)));
typedef __bf16 bf16x2_t __attribute__((ext_vector_type(2)));

constexpr int BATCH = 4, SEQ = 8192, DM = 1024, T = BATCH * SEQ, DEPTH = 4;
constexpr int NSA_IN = 2608, NSA_INP = 2816;
constexpr int PC_KC = 1024, PC_VC = 1280, PC_KS = 1536, PC_VS = 1792, PC_KW = 2048, PC_VW = 2304, PC_GT = 2560;
constexpr int MLA_IN = 576, MLA_INP = 768;
constexpr int NCMP = 511, NCMPP = 512;
constexpr int NEXP = 64, MOE_FF = 256;
constexpr float RMS_EPS = 1e-6f;
constexpr float LOG2E = 1.4426950408889634f;
constexpr float NSA_QS = 0.125f * LOG2E;
constexpr float MLA_QS = 0.07216878364870322f * LOG2E;
constexpr int NWAVES = 8, NTHREADS = 512;

constexpr size_t MiB = 1u << 20;
constexpr size_t WS_CTL = 0, CTL_ZERO_BYTES = 1 * MiB;
constexpr size_t WS_ROPE = 1 * MiB;
constexpr size_t WS_RW = 3 * MiB;
constexpr size_t WS_CMPB = 5 * MiB;
constexpr size_t WS_NSA_WIN = 6 * MiB;
constexpr size_t WS_NSA_WOUT = 18 * MiB;
constexpr size_t WS_CMP_W1T = 22 * MiB;
constexpr size_t WS_MLA_WIN = 26 * MiB;
constexpr size_t WS_MLA_WUQ = 29 * MiB;
constexpr size_t WS_MLA_WUKV = 31 * MiB;
constexpr size_t WS_MLA_WOUT = 33 * MiB;
constexpr size_t WS_MOE_W1 = 40 * MiB;
constexpr size_t WS_MOE_W2 = 104 * MiB;
constexpr size_t WS_H = 136 * MiB;
constexpr size_t WS_O = 200 * MiB;
constexpr size_t WS_GATES = 264 * MiB;
constexpr size_t WS_HID = 272 * MiB;
constexpr size_t WS_KCMP = 276 * MiB;
constexpr size_t WS_VCMP = 277 * MiB;
constexpr size_t WS_ROUTE = 278 * MiB;
constexpr size_t WS_ROWLIST = 282 * MiB;
constexpr size_t WS_PBUF = 290 * MiB;
constexpr size_t WS_QA = 562 * MiB;
constexpr size_t WS_ROWW = 820 * MiB;
constexpr size_t WS_MOE_W1B = 830 * MiB;
constexpr size_t WS_MOE_W2B = 894 * MiB;
constexpr size_t WS_END = 926 * MiB;
constexpr int CW_BAR = 4096, CW_CNT = 8192;

constexpr int LDS_MISC = 155648;
constexpr int LDS_BYTES = 155648 + 1024;

DI unsigned f2bf(float f) { unsigned u = __builtin_bit_cast(unsigned, f); return (u + 0x7fffu + ((u >> 16) & 1u)) >> 16; }
DI unsigned pk2(float lo, float hi) { f32x2 v = {lo, hi}; bf16x2_t b = __builtin_convertvector(v, bf16x2_t); return __builtin_bit_cast(unsigned, b); }
DI float bf2f(unsigned short h) { return __builtin_bit_cast(float, (unsigned)h << 16); }
DI float bflo(unsigned w) { return __builtin_bit_cast(float, w << 16); }
DI float bfhi(unsigned w) { return __builtin_bit_cast(float, w & 0xffff0000u); }
DI float fast_exp2(float x) { return __builtin_amdgcn_exp2f(x); }
DI float fast_rcp(float x) { return __builtin_amdgcn_rcpf(x); }
#define LDS_WAIT() asm volatile("s_waitcnt lgkmcnt(0)" ::: "memory")
DI unsigned char* opq_p(unsigned char* p) { unsigned long long v = (unsigned long long)p; asm volatile("" : "+s"(v)); return (unsigned char*)v; }
DI int lane_id() { int x; asm volatile("v_mbcnt_lo_u32_b32 %0, -1, 0\n\tv_mbcnt_hi_u32_b32 %0, -1, %0" : "=v"(x)); return x; }
DI float shx(float v, int o) { return __int_as_float(__builtin_amdgcn_ds_bpermute((lane_id() ^ o) << 2, __float_as_int(v))); }
DI float wave_sum(float v) {
#pragma unroll
    for (int o = 1; o < 64; o <<= 1) v += shx(v, o);
    return v;
}
DI int opq(int x) { asm volatile("" : "+v"(x)); return x; }

#define XB_TMO      128
#define XB_XCNT(j)  (256  + 64 * (j))
#define XB_XSUB(j)  (1280 + 64 * (j))
#define XB_XGEN(j)  (2304 + 64 * (j))
#define XB_TOP      3328
#define XB_TOPGEN   3392
#define XCD_BAR_WORDS 3456
#define XB_SPIN_CAP (1u << 18)
DI unsigned xb_ld(unsigned* p)              { return __hip_atomic_load(p, __ATOMIC_RELAXED, __HIP_MEMORY_SCOPE_AGENT); }
DI unsigned xb_add(unsigned* p, unsigned v) { return __hip_atomic_fetch_add(p, v, __ATOMIC_RELAXED, __HIP_MEMORY_SCOPE_AGENT); }
DI unsigned xb_xcc_id() { return (unsigned)__builtin_amdgcn_s_getreg((3 << 11) | 20) & 0xFu; }
#define XB_SPIN(cond, bar) do { unsigned _sp = 0; while (cond) { __builtin_amdgcn_s_sleep(1); \
    if ((++_sp & 255u) == 0u) { if (xb_ld(&(bar)[XB_TMO])) break; if (_sp > XB_SPIN_CAP) { atomicAdd(&(bar)[XB_TMO], 1u); break; } } } } while (0)
struct XcdBarrier { unsigned* bar; unsigned x; volatile LAS unsigned* st; };
DI XcdBarrier xcd_barrier_post(unsigned* bar, volatile LAS unsigned* st, bool t0) {
    XcdBarrier b; b.bar = bar; b.x = xb_xcc_id(); b.st = st;
    if (t0) (void)xb_add(&bar[XB_XCNT(b.x)], 1u);
    return b;
}
DI void xcd_barrier_complete(unsigned* bar, unsigned x, unsigned& nloc, unsigned& nx) {
    const unsigned G = gridDim.x * gridDim.y * gridDim.z;
    unsigned sum, cnt, mine, sp = 0u;
    for (;;) {
        sum = 0u; cnt = 0u; mine = 0u;
#pragma unroll
        for (unsigned j = 0; j < 16; ++j) { const unsigned c = xb_ld(&bar[XB_XCNT(j)]); sum += c; cnt += (c > 0u) ? 1u : 0u; mine = (j == x) ? c : mine; }
        if (sum == G) break;
        __builtin_amdgcn_s_sleep(1);
        if ((++sp & 255u) == 0u) { if (xb_ld(&bar[XB_TMO])) break; if (sp > XB_SPIN_CAP) { atomicAdd(&bar[XB_TMO], 1u); break; } }
    }
    nloc = mine > 0u ? mine : 1u; nx = cnt > 0u ? cnt : 1u;
}
DI void xcd_barrier(const XcdBarrier& b, bool t0) {
    asm volatile("s_waitcnt vmcnt(0)" ::: "memory");
    __syncthreads();
    if (t0) {
        unsigned* bar = b.bar;
        __builtin_amdgcn_s_waitcnt(0);
        unsigned nloc = b.st[0], nx = b.st[1];
        if (nloc == 0u) { xcd_barrier_complete(bar, b.x, nloc, nx); b.st[0] = nloc; b.st[1] = nx; }
        const unsigned old = xb_add(&bar[XB_XSUB(b.x)], 1u);
        const unsigned gen = old / nloc;
        if (old + 1u == (gen + 1u) * nloc) {
            __builtin_amdgcn_fence(__ATOMIC_RELEASE, "agent");
            asm volatile("s_waitcnt vmcnt(0)" ::: "memory");
            const unsigned og = xb_add(&bar[XB_TOP], 1u);
            const unsigned tg = og / nx;
            __builtin_amdgcn_fence(__ATOMIC_ACQUIRE, "agent");
            if (og + 1u == (tg + 1u) * nx) xb_add(&bar[XB_TOPGEN], 1u);
            else XB_SPIN(xb_ld(&bar[XB_TOPGEN]) == tg, bar);
            __builtin_amdgcn_fence(__ATOMIC_ACQUIRE, "wavefront");
            xb_add(&bar[XB_XGEN(b.x)], 1u);
            asm volatile("s_waitcnt vmcnt(0)" ::: "memory");
        } else {
            __builtin_amdgcn_fence(__ATOMIC_ACQUIRE, "agent");
            XB_SPIN(xb_ld(&bar[XB_XGEN(b.x)]) == gen, bar);
            __builtin_amdgcn_fence(__ATOMIC_ACQUIRE, "wavefront");
            asm volatile("s_waitcnt vmcnt(0)" ::: "memory");
        }
    }
    __syncthreads();
}

namespace pg8 {
constexpr int BM = 256, BK = 64, HALF = 128, HTB = HALF * BK * 2, NXCD = 8, WGM = 8;
DI int lds_byte(int r, int c) { const int st = (r >> 4) * 2 + (c >> 5), rr = r & 15, cc = c & 31, ob = rr * 64 + cc * 2; return st * 1024 + (ob ^ (((ob >> 9) & 1) << 5)); }
DI void stage_rc(int b, int& R, int& C) { const int st = b / 1024, sb = b % 1024, swz = sb ^ (((sb >> 9) & 1) << 5); R = (st >> 1) * 16 + swz / 64; C = (st & 1) * 32 + (swz % 64) / 2; }
DI int perm32(int rho) { const int n = rho >> 4, i = rho & 15; return 8 * (i >> 2) + 4 * n + (i & 3); }

struct Unit { const char* A; const char* B; char* out; int ldc; const int* rows; int nvalid; int aux; int row0; };
struct GemmGeo { int K; int lda; int ldb; unsigned kstepA; };

typedef f32x4 Acc[2][2][4][2];

template <class Epi, class Sched, bool GATHER, bool HALFN = false>
DI void gemm_phase(LAS unsigned char* lds, int tid_, const GemmGeo g, const Sched& S, const Epi& E) {
    const int tid = tid_, wid = __builtin_amdgcn_readfirstlane(tid >> 6), lane = tid & 63, wr = wid >> 2, wc = wid & 3, fr = lane & 15, fq = lane >> 4;
    const int K = g.K, nt = K / BK;
    unsigned voffB[2]; unsigned cuA[2][2], nxA[2][2]; int RA[2], CA[2];
    const unsigned hstepA = (unsigned)HALF * (unsigned)g.lda * 2u;
#pragma unroll
    for (int i = 0; i < 2; ++i) { int R, C; stage_rc(tid * 16 + i * 8192, R, C); const int Rb = (R & ~31) + perm32(R & 31);
        RA[i] = R; CA[i] = C; voffB[i] = (unsigned)(Rb * g.ldb + C) * 2u;
        cuA[0][i] = (unsigned)(R * g.lda + C) * 2u; cuA[1][i] = cuA[0][i] + hstepA; nxA[0][i] = cuA[0][i]; nxA[1][i] = cuA[1][i]; }
    const size_t kstepA = g.kstepA, kstepB = (size_t)(BK * 2);
    const size_t hstepB = (size_t)HALF * g.ldb * 2;
    const unsigned ldsw = (unsigned)wid * 1024u;
    const int aoff = lds_byte(wr * 64 + fr, fq * 8), boff = lds_byte(wc * 32 + fr, fq * 8);
#define PG8_SA(b, h) (((b) * 2 + (h)) * HTB)
#define PG8_SB(b, h) ((4 + (b) * 2 + (h)) * HTB)
#define PG8_STAGEB(bufoff, gbase) do { _Pragma("unroll") for (int _i = 0; _i < 2; ++_i) \
        __builtin_amdgcn_global_load_lds((const unsigned*)((const char*)(gbase) + voffB[_i]), (LAS unsigned*)(lds + (bufoff) + ldsw + _i * 8192), 16, 0, 0); } while (0)
#define PG8_STAGEA(bufoff, gbase, o0, o1) do { \
        __builtin_amdgcn_global_load_lds((const unsigned*)((const char*)(gbase) + (o0)), (LAS unsigned*)(lds + (bufoff) + ldsw), 16, 0, 0); \
        __builtin_amdgcn_global_load_lds((const unsigned*)((const char*)(gbase) + (o1)), (LAS unsigned*)(lds + (bufoff) + ldsw + 8192), 16, 0, 0); } while (0)
#define PG8_LDA(dst, b, h) do { _Pragma("unroll") for (int m = 0; m < 4; ++m) _Pragma("unroll") for (int k = 0; k < 2; ++k) dst[m][k] = *(const LAS bf16x8*)(lds + PG8_SA(b, h) + aoff + m * 2048 + k * 1024); } while (0)
#define PG8_LDB(dst, b, h) do { _Pragma("unroll") for (int n = 0; n < 2; ++n) _Pragma("unroll") for (int k = 0; k < 2; ++k) dst[n][k] = *(const LAS bf16x8*)(lds + PG8_SB(b, h) + boff + n * 2048 + k * 1024); } while (0)
#define PG8_MMA(ai, bj, At, Bt) do { __builtin_amdgcn_s_setprio(1); _Pragma("unroll") for (int m = 0; m < 4; ++m) _Pragma("unroll") for (int n = 0; n < 2; ++n) _Pragma("unroll") for (int k = 0; k < 2; ++k) \
        acc[ai][bj][m][n] = __builtin_amdgcn_mfma_f32_16x16x32_bf16(Bt[n][k], At[m][k], acc[ai][bj][m][n], 0, 0, 0); __builtin_amdgcn_s_setprio(0); } while (0)
#define PG8_WAIT_V(n) asm volatile("s_waitcnt vmcnt(" #n ")" ::: "memory")
#define PG8_WAIT_L(n) asm volatile("s_waitcnt lgkmcnt(" #n ")" ::: "memory")
#define PG8_BAR __builtin_amdgcn_s_barrier()
#define PG8_SCHED __builtin_amdgcn_sched_barrier(0)
#define PG8_GOFF(u_, dst) do { if constexpr (GATHER) { _Pragma("unroll") for (int _h = 0; _h < 2; ++_h) _Pragma("unroll") for (int _i = 0; _i < 2; ++_i) { \
        const int _r = RA[_i] + _h * HALF; const int _t = (_r < (u_).nvalid) ? ((u_).rows[_r] >> 1) : 0; dst[_h][_i] = ((unsigned)_t * (unsigned)g.lda + (unsigned)CA[_i]) * 2u; } } } while (0)
    Unit cur, nxt; int ui = 0;
    if (!S.next(0, cur)) return;
    Acc acc;
#pragma unroll
    for (int a = 0; a < 2; ++a)
#pragma unroll
        for (int b = 0; b < 2; ++b)
#pragma unroll
            for (int m = 0; m < 4; ++m)
#pragma unroll
                for (int n = 0; n < 2; ++n) acc[a][b][m][n] = (f32x4){0.f, 0.f, 0.f, 0.f};
    bf16x8 At[4][2], B0[2][2], B1[2][2];
    const char* cA = cur.A; const char* cB = cur.B;
    PG8_GOFF(cur, cuA);
    PG8_STAGEB(PG8_SB(0, 0), cB); PG8_STAGEB(PG8_SB(0, 1), cB + hstepB); PG8_STAGEA(PG8_SA(0, 0), cA, cuA[0][0], cuA[0][1]); PG8_STAGEA(PG8_SA(0, 1), cA, cuA[1][0], cuA[1][1]);
    if (wr == 1) PG8_BAR;
    PG8_WAIT_V(2); PG8_BAR;
    PG8_STAGEB(PG8_SB(1, 0), cB + kstepB); PG8_STAGEA(PG8_SA(1, 0), cA + kstepA, cuA[0][0], cuA[0][1]); PG8_STAGEB(PG8_SB(1, 1), cB + hstepB + kstepB);
    PG8_WAIT_V(6); PG8_BAR;
    for (;;) {
        u32x2 prev = {0u, 0u}; f32x4 pre8a = {0.f, 0.f, 0.f, 0.f}, pre8b = {0.f, 0.f, 0.f, 0.f};
        if constexpr (Epi::PRE) prev = E.pre(cur, tid);
        if constexpr (Epi::PRE8) E.pre8(cur, wr, fr, pre8a, pre8b);
        const bool has_next = S.next(ui + 1, nxt);
        const char* nA = has_next ? nxt.A : cA; const char* nB = has_next ? nxt.B : cB;
        if constexpr (GATHER) { if (has_next) { PG8_GOFF(nxt, nxA); } else {
#pragma unroll
            for (int h = 0; h < 2; ++h)
#pragma unroll
                for (int i = 0; i < 2; ++i) nxA[h][i] = cuA[h][i]; } }
#pragma unroll 1
        for (int t = 0; t < nt; t += 2) {
            const bool last = (t == nt - 2);
            const char* a1 = cA + (size_t)(t + 1) * kstepA;
            const char* a2 = last ? nA : cA + (size_t)(t + 2) * kstepA; const char* b2 = last ? nB : cB + (size_t)(t + 2) * kstepB;
            const char* a3 = a2 + kstepA; const char* b3 = b2 + kstepB;
            unsigned o00, o01, o10, o11;
            if constexpr (GATHER) { o00 = last ? nxA[0][0] : cuA[0][0]; o01 = last ? nxA[0][1] : cuA[0][1]; o10 = last ? nxA[1][0] : cuA[1][0]; o11 = last ? nxA[1][1] : cuA[1][1]; }
            else { o00 = cuA[0][0]; o01 = cuA[0][1]; o10 = cuA[1][0]; o11 = cuA[1][1]; }
            PG8_LDB(B0, 0, 0); if constexpr (!HALFN) PG8_LDB(B1, 0, 1); PG8_SCHED; PG8_LDA(At, 0, 0); PG8_STAGEA(PG8_SA(1, 1), a1, cuA[1][0], cuA[1][1]);
            PG8_WAIT_V(8); PG8_WAIT_L(0); PG8_BAR; PG8_MMA(0, 0, At, B0); if constexpr (!HALFN) PG8_MMA(0, 1, At, B1); PG8_BAR; PG8_SCHED;
            PG8_LDA(At, 0, 1); PG8_STAGEB(PG8_SB(0, 0), b2); PG8_STAGEB(PG8_SB(0, 1), b2 + hstepB); PG8_STAGEA(PG8_SA(0, 0), a2, o00, o01);
            PG8_WAIT_V(8); PG8_WAIT_L(0); PG8_BAR; PG8_MMA(1, 0, At, B0); if constexpr (!HALFN) PG8_MMA(1, 1, At, B1); PG8_BAR; PG8_SCHED;
            PG8_LDB(B0, 1, 0); if constexpr (!HALFN) PG8_LDB(B1, 1, 1); PG8_SCHED; PG8_LDA(At, 1, 0); PG8_STAGEA(PG8_SA(0, 1), a2, o10, o11);
            PG8_WAIT_V(8); PG8_WAIT_L(0); PG8_BAR; PG8_MMA(0, 0, At, B0); if constexpr (!HALFN) PG8_MMA(0, 1, At, B1); PG8_BAR; PG8_SCHED;
            PG8_LDA(At, 1, 1); PG8_STAGEB(PG8_SB(1, 0), b3); PG8_STAGEB(PG8_SB(1, 1), b3 + hstepB); PG8_STAGEA(PG8_SA(1, 0), a3, o00, o01);
            PG8_WAIT_V(8); PG8_WAIT_L(0); PG8_BAR; PG8_MMA(1, 0, At, B0); if constexpr (!HALFN) PG8_MMA(1, 1, At, B1); PG8_BAR; PG8_SCHED;
        }
        if (wr == 0) PG8_BAR;
        if constexpr (Epi::PRE) E(acc, cur, wr, wc, fr, fq, prev, tid); else if constexpr (Epi::PRE8) E(acc, cur, wr, wc, fr, fq, pre8a, pre8b); else E(acc, cur, wr, wc, fr, fq);
        if (!has_next) break;
#pragma unroll
        for (int a = 0; a < 2; ++a)
#pragma unroll
            for (int b = 0; b < 2; ++b)
#pragma unroll
                for (int m = 0; m < 4; ++m)
#pragma unroll
                    for (int n = 0; n < 2; ++n) acc[a][b][m][n] = (f32x4){0.f, 0.f, 0.f, 0.f};
        cur = nxt; cA = nA; cB = nB; ++ui;
        if constexpr (GATHER) {
#pragma unroll
            for (int h = 0; h < 2; ++h)
#pragma unroll
                for (int i = 0; i < 2; ++i) cuA[h][i] = nxA[h][i]; }
        if (wr == 1) PG8_BAR;
    }
    PG8_WAIT_V(0);
    PG8_BAR;
#undef PG8_SA
#undef PG8_SB
#undef PG8_STAGEA
#undef PG8_STAGEB
#undef PG8_LDA
#undef PG8_LDB
#undef PG8_MMA
#undef PG8_WAIT_V
#undef PG8_WAIT_L
#undef PG8_BAR
#undef PG8_SCHED
#undef PG8_GOFF
}
}
namespace pg8 {
constexpr int XCH_OFF_ = 131072;
DI u32x4 pack8(const f32x4& a, const f32x4& b) { u32x4 w; w.x = pk2(a[0], a[1]); w.y = pk2(a[2], a[3]); w.z = pk2(b[0], b[1]); w.w = pk2(b[2], b[3]); return w; }

struct EpiStoreBf16 {
    static constexpr bool PRE = false, PRE8 = false;
    DI void operator()(const Acc& acc, const Unit& u, int wr, int wc, int fr, int fq) const {
        bf16_t* base = (bf16_t*)u.out + (size_t)(wr * 64 + fr) * u.ldc + wc * 32 + 8 * fq;
#pragma unroll
        for (int ai = 0; ai < 2; ++ai)
#pragma unroll
            for (int m = 0; m < 4; ++m) { bf16_t* rowp = base + (size_t)(ai * HALF + m * 16) * u.ldc;
#pragma unroll
                for (int bj = 0; bj < 2; ++bj) *(u32x4*)(rowp + bj * HALF) = pack8(acc[ai][bj][m][0], acc[ai][bj][m][1]); }
    }
};
struct EpiResid {
    static constexpr bool PRE = false, PRE8 = false;
    DI void operator()(const Acc& acc, const Unit& u, int wr, int wc, int fr, int fq) const {
        float* base = (float*)u.out + (size_t)(wr * 64 + fr) * u.ldc + wc * 32 + 8 * fq;
#pragma unroll
        for (int ai = 0; ai < 2; ++ai)
#pragma unroll
            for (int m = 0; m < 4; ++m) { float* rowp = base + (size_t)(ai * HALF + m * 16) * u.ldc;
#pragma unroll
                for (int bj = 0; bj < 2; ++bj) { f32x4* p = (f32x4*)(rowp + bj * HALF); f32x4 a = p[0], b = p[1]; a = a + acc[ai][bj][m][0]; b = b + acc[ai][bj][m][1]; p[0] = a; p[1] = b; } }
    }
};
struct EpiResidB {
    static constexpr bool PRE = false, PRE8 = false;
    DI void operator()(const Acc& acc, const Unit& u, int wr, int wc, int fr, int fq) const {
        bf16_t* base = (bf16_t*)u.out + (size_t)(wr * 64 + fr) * u.ldc + wc * 32 + 8 * fq;
#pragma unroll
        for (int ai = 0; ai < 2; ++ai)
#pragma unroll
            for (int m = 0; m < 4; ++m) { bf16_t* rowp = base + (size_t)(ai * HALF + m * 16) * u.ldc;
#pragma unroll
                for (int bj = 0; bj < 2; ++bj) { u32x4* p = (u32x4*)(rowp + bj * HALF); const u32x4 w = *p;
                    f32x4 a = {bflo(w.x), bfhi(w.x), bflo(w.y), bfhi(w.y)}, b = {bflo(w.z), bfhi(w.z), bflo(w.w), bfhi(w.w)};
                    a = a + acc[ai][bj][m][0]; b = b + acc[ai][bj][m][1]; *p = pack8(a, b); } }
    }
};
DI float gelu_tanh(float x) {
    const float z = x + 0.044715f * x * x * x;
    const float e = fast_exp2(-2.0f * 0.7978845608028654f * LOG2E * z);
    return x * fast_rcp(1.0f + e);
}
struct EpiCmpGelu {
    static constexpr bool PRE = false, PRE8 = false;
    const float* bias;
    DI void operator()(const Acc& acc, const Unit& u, int wr, int wc, int fr, int fq) const {
        bf16_t* base = (bf16_t*)u.out + (size_t)(wr * 64 + fr) * 128 + wc * 32 + 8 * fq;
        const float* bp = bias + u.aux * 128 + wc * 32 + 8 * fq;
        const f32x4 b0 = *(const f32x4*)bp, b1 = *(const f32x4*)(bp + 4);
#pragma unroll
        for (int ai = 0; ai < 2; ++ai)
#pragma unroll
            for (int m = 0; m < 4; ++m) { f32x4 v0 = acc[ai][0][m][0] + b0, v1 = acc[ai][0][m][1] + b1;
#pragma unroll
                for (int i = 0; i < 4; ++i) { v0[i] = gelu_tanh(v0[i]); v1[i] = gelu_tanh(v1[i]); }
                *(u32x4*)(base + (size_t)(ai * HALF + m * 16) * 128) = pack8(v0, v1); }
    }
};
struct EpiSwiGLU {
    static constexpr bool PRE = false, PRE8 = false;
    DI void operator()(const Acc& acc, const Unit& u, int wr, int wc, int fr, int fq) const {
        bf16_t* base = (bf16_t*)u.out + (size_t)(wr * 64 + fr) * MOE_FF + wc * 32 + 8 * fq;
#pragma unroll
        for (int ai = 0; ai < 2; ++ai)
#pragma unroll
            for (int m = 0; m < 4; ++m) { f32x4 h0, h1;
#pragma unroll
                for (int i = 0; i < 4; ++i) { const float g0 = acc[ai][0][m][0][i], g1 = acc[ai][0][m][1][i];
                    h0[i] = g0 * fast_rcp(1.0f + fast_exp2(-LOG2E * g0)) * acc[ai][1][m][0][i];
                    h1[i] = g1 * fast_rcp(1.0f + fast_exp2(-LOG2E * g1)) * acc[ai][1][m][1][i]; }
                *(u32x4*)(base + (size_t)(ai * HALF + m * 16) * MOE_FF) = pack8(h0, h1); }
    }
};
struct EpiMoeOut {
    static constexpr bool PRE = true, PRE8 = false;
    bf16_t* y2;
    DI u32x2 pre(const Unit& u, int tid) const { u32x2 r = {0u, 0u};
        if (tid < u.nvalid) { r.x = (unsigned)*(const GAS int*)(u.rows + tid); r.y = __float_as_uint(*(const GAS float*)((const float*)u.out + tid)); } return r; }
    DI void operator()(const Acc& acc, const Unit& u, int wr, int wc, int fr, int fq, u32x2 pv, int tid) const {
        LAS u32x2* Tb = (LAS u32x2*)XCH_OFF_;
        if (tid < 256) Tb[tid] = pv;
        asm volatile("s_waitcnt lgkmcnt(0)\n\ts_barrier" ::: "memory");
#pragma unroll
        for (int ai = 0; ai < 2; ++ai)
#pragma unroll
            for (int m = 0; m < 4; ++m) { const int r = ai * HALF + wr * 64 + m * 16 + fr;
                if (r < u.nvalid) { const u32x2 e = Tb[r]; const int a = (int)e.x; const float w = __uint_as_float(e.y);
                    bf16_t* dst = y2 + (size_t)a * DM + u.aux + wc * 32 + 8 * fq;
#pragma unroll
                    for (int bj = 0; bj < 2; ++bj) { f32x4 v0 = acc[ai][bj][m][0] * w, v1 = acc[ai][bj][m][1] * w; *(u32x4*)(dst + bj * HALF) = pack8(v0, v1); } } }
    }
};

constexpr int XCH_OFF = 131072;
DI void epi_bar() { asm volatile("s_waitcnt lgkmcnt(0)\n\ts_barrier" ::: "memory"); }
DI float sq4(const f32x4& a) { return (a[0] * a[0] + a[1] * a[1]) + (a[2] * a[2] + a[3] * a[3]); }
DI float fq_sum(float s) {
    auto a = __builtin_amdgcn_permlane16_swap(__float_as_uint(s), __float_as_uint(s), false, false); s = __uint_as_float(a[0]) + __uint_as_float(a[1]);
    auto b = __builtin_amdgcn_permlane32_swap(__float_as_uint(s), __float_as_uint(s), false, false); return __uint_as_float(b[0]) + __uint_as_float(b[1]);
}
DI u32x2 pack4(const f32x4& a) { u32x2 w; w.x = pk2(a[0], a[1]); w.y = pk2(a[2], a[3]); return w; }
struct EpiMlaIn {
    static constexpr bool PRE = false, PRE8 = false;
    unsigned char* ws; const float* const* in; int j;
    DI void operator()(const Acc& acc, const Unit& u, int wr, int wc, int fr, int fq) const {
        fr = opq(fr); fq = opq(fq);
        const int pn = u.aux;
        bf16_t* C1 = (bf16_t*)(ws + WS_PBUF); float* rq = (float*)(ws + WS_GATES); float* rkv = (float*)(ws + WS_GATES + MiB); bf16_t* kr = (bf16_t*)(ws + WS_HID);
        const float* ct = (const float*)(ws + WS_ROPE); const float* st = ct + SEQ * 32; LAS float* X = (LAS float*)XCH_OFF;
        if (pn < 2) {
            bf16_t* base = C1 + (size_t)(u.row0 + wr * 64 + fr) * MLA_INP + pn * 256 + wc * 32 + 8 * fq;
#pragma unroll
            for (int ai = 0; ai < 2; ++ai)
#pragma unroll
                for (int m = 0; m < 4; ++m) { bf16_t* rowp = base + (size_t)(ai * HALF + m * 16) * MLA_INP;
#pragma unroll
                    for (int bj = 0; bj < 2; ++bj) *(u32x4*)(rowp + bj * HALF) = pack8(acc[ai][bj][m][0], acc[ai][bj][m][1]);
                    const float sp = fq_sum((sq4(acc[ai][0][m][0]) + sq4(acc[ai][0][m][1])) + (sq4(acc[ai][1][m][0]) + sq4(acc[ai][1][m][1])));
                    if (fq == 0) X[(ai * HALF + wr * 64 + m * 16 + fr) * 8 + wc] = sp; }
            epi_bar();
            if (wc == 0 && fq == 0) { float* dst = pn == 0 ? rq : rkv;
#pragma unroll
                for (int ai = 0; ai < 2; ++ai)
#pragma unroll
                    for (int m = 0; m < 4; ++m) { const int r = ai * HALF + wr * 64 + m * 16 + fr; const f32x4 pp = *(const LAS f32x4*)(X + r * 8);
                        dst[u.row0 + r] = __builtin_amdgcn_rsqf(((pp[0] + pp[1]) + (pp[2] + pp[3])) * (1.0f / 256.0f) + RMS_EPS); } }
        } else {
#pragma unroll
            for (int ai = 0; ai < 2; ++ai)
#pragma unroll
                for (int m = 0; m < 4; ++m) { const float sp = fq_sum(wc < 2 ? sq4(acc[ai][0][m][0]) + sq4(acc[ai][0][m][1]) : 0.f);
                    if (fq == 0 && wc < 2) X[(ai * HALF + wr * 64 + m * 16 + fr) * 8 + wc] = sp; }
            epi_bar();
            if (wc < 2) { const float* gkr = in[18] + j * 64; const int d0 = 4 * (4 * wc + fq); const f32x4 g1 = *(const f32x4*)(gkr + d0), g2 = *(const f32x4*)(gkr + 32 + d0);
#pragma unroll
                for (int ai = 0; ai < 2; ++ai)
#pragma unroll
                    for (int m = 0; m < 4; ++m) { const int r = ai * HALF + wr * 64 + m * 16 + fr; const int grow = u.row0 + r, t = grow & (SEQ - 1);
                        const float rs = __builtin_amdgcn_rsqf((X[r * 8] + X[r * 8 + 1]) * (1.0f / 64.0f) + RMS_EPS);
                        const f32x4 c4 = *(const f32x4*)(ct + t * 32 + d0), s4 = *(const f32x4*)(st + t * 32 + d0);
                        const f32x4 x1 = acc[ai][0][m][0] * rs * g1, x2 = acc[ai][0][m][1] * rs * g2;
                        const f32x4 o1 = x1 * c4 - x2 * s4, o2 = x2 * c4 + x1 * s4;
                        *(u32x2*)(kr + (size_t)grow * 64 + d0) = pack4(o1); *(u32x2*)(kr + (size_t)grow * 64 + 32 + d0) = pack4(o2); } }
        }
    }
};
struct EpiMlaUp {
    static constexpr bool PRE = false, PRE8 = true;
    unsigned char* ws; const float* const* in; int j;
    DI void pre8(const Unit& u, int wr, int fr, f32x4& pa, f32x4& pb) const {
        const float* rl = (const float*)(ws + WS_GATES + (u.aux < 6 ? 0 : MiB)) + u.row0 + wr * 64 + fr;
#pragma unroll
        for (int m = 0; m < 4; ++m) { pa[m] = *(const GAS float*)(rl + m * 16); pb[m] = *(const GAS float*)(rl + HALF + m * 16); }
    }
    DI void operator()(const Acc& acc, const Unit& u, int wr, int wc, int fr, int fq, const f32x4& pa_, const f32x4& pb_) const {
        fr = opq(fr); fq = opq(fq);
        const int aux = u.aux;
        LAS float* X = (LAS float*)XCH_OFF;
        bf16_t* Qf = (bf16_t*)(ws + WS_QA); bf16_t* Kn = Qf + (size_t)T * 1536; bf16_t* Vf = Kn + (size_t)T * DM;
        float rlat[2][4];
#pragma unroll
        for (int m = 0; m < 4; ++m) { rlat[0][m] = pa_[m]; rlat[1][m] = pb_[m]; }
        const int cb = wc * 32 + 8 * fq;
        const bool kv = aux >= 6;
#pragma unroll
        for (int ai = 0; ai < 2; ++ai)
#pragma unroll
            for (int m = 0; m < 4; ++m) { const float rr = rlat[ai][m] * rlat[ai][m]; const int r = ai * HALF + wr * 64 + m * 16 + fr;
                const float s0 = fq_sum((sq4(acc[ai][0][m][0]) + sq4(acc[ai][0][m][1])) * rr);
                const float s1 = fq_sum((sq4(acc[ai][1][m][0]) + sq4(acc[ai][1][m][1])) * rr);
                if (fq == 0) { X[r * 8 + wc] = s0; X[r * 8 + 4 + wc] = s1; } }
        epi_bar();
        if (aux < 4 || kv) {
            const float* g = (kv ? in[17] : in[15]) + j * 128; const f32x4 g0 = *(const f32x4*)(g + cb), g1 = *(const f32x4*)(g + cb + 4);
            const float qs = kv ? 1.0f : MLA_QS;
#pragma unroll
            for (int ai = 0; ai < 2; ++ai)
#pragma unroll
                for (int m = 0; m < 4; ++m) { const int r = ai * HALF + wr * 64 + m * 16 + fr; const size_t grow = (size_t)(u.row0 + r);
                    const f32x4 pa = *(const LAS f32x4*)(X + r * 8), pb = *(const LAS f32x4*)(X + r * 8 + 4);
                    const float rsA = rlat[ai][m] * __builtin_amdgcn_rsqf(((pa[0] + pa[1]) + (pa[2] + pa[3])) * (1.0f / 128.0f) + RMS_EPS) * qs;
                    const f32x4 a0 = acc[ai][0][m][0] * rsA * g0, a1 = acc[ai][0][m][1] * rsA * g1;
                    if (!kv) {
                        const float rsB = rlat[ai][m] * __builtin_amdgcn_rsqf(((pb[0] + pb[1]) + (pb[2] + pb[3])) * (1.0f / 128.0f) + RMS_EPS) * qs;
                        const f32x4 b0 = acc[ai][1][m][0] * rsB * g0, b1 = acc[ai][1][m][1] * rsB * g1;
                        *(u32x4*)(Qf + grow * 1536 + (2 * aux) * 192 + cb) = pack8(a0, a1);
                        *(u32x4*)(Qf + grow * 1536 + (2 * aux + 1) * 192 + cb) = pack8(b0, b1);
                    } else {
                        const f32x4 b0 = acc[ai][1][m][0] * rlat[ai][m], b1 = acc[ai][1][m][1] * rlat[ai][m];
                        *(u32x4*)(Kn + grow * DM + (aux - 6) * 128 + cb) = pack8(a0, a1);
                        *(u32x4*)(Vf + grow * DM + (aux - 6) * 128 + cb) = pack8(b0, b1);
                    } }
        } else {
            const float* gqr = in[16] + j * 64; const float* ct = (const float*)(ws + WS_ROPE); const float* st = ct + SEQ * 32;
            const int d0 = 4 * (4 * (wc & 1) + fq); const f32x4 g1 = *(const f32x4*)(gqr + d0), g2 = *(const f32x4*)(gqr + 32 + d0);
#pragma unroll
            for (int ai = 0; ai < 2; ++ai)
#pragma unroll
                for (int m = 0; m < 4; ++m) { const int r = ai * HALF + wr * 64 + m * 16 + fr; const size_t grow = (size_t)(u.row0 + r); const int t = (int)grow & (SEQ - 1);
                    const f32x4 c4 = *(const f32x4*)(ct + t * 32 + d0), s4 = *(const f32x4*)(st + t * 32 + d0);
#pragma unroll
                    for (int bj = 0; bj < 2; ++bj) { const float tot = X[r * 8 + bj * 4 + (wc & 2)] + X[r * 8 + bj * 4 + (wc & 2) + 1];
                        const float rs = rlat[ai][m] * __builtin_amdgcn_rsqf(tot * (1.0f / 64.0f) + RMS_EPS) * MLA_QS;
                        const f32x4 x1 = acc[ai][bj][m][0] * rs * g1, x2 = acc[ai][bj][m][1] * rs * g2;
                        const f32x4 o1 = x1 * c4 - x2 * s4, o2 = x2 * c4 + x1 * s4;
                        bf16_t* dst = Qf + grow * 1536 + ((aux - 4) * 4 + 2 * bj + (wc >> 1)) * 192 + 128 + d0;
                        *(u32x2*)dst = pack4(o1); *(u32x2*)(dst + 32) = pack4(o2); } }
        }
    }
};

struct DenseSched {
    const char* A; const char* B; char* out; int lda, ldb, ldc, esz; int nM, nN, nwg, G, c;
    DI void init(const void* A_, int lda_, const void* B_, int ldb_, void* out_, int ldc_, int esz_, int M, int N, int G_, int c_) {
        A = (const char*)A_; B = (const char*)B_; out = (char*)out_; lda = lda_; ldb = ldb_; ldc = ldc_; esz = esz_; nM = M / BM; nN = N / BM; nwg = nM * nN; G = G_; c = c_; }
    DI bool next(int i, Unit& u) const {
        const long L = (long)i * G + c; if (L >= nwg) return false;
        int wgid = (int)L; { const int q = nwg / NXCD, r = nwg % NXCD, xcd = wgid % NXCD, off = wgid / NXCD; wgid = (xcd < r ? xcd * (q + 1) : r * (q + 1) + (xcd - r) * q) + off; }
        const int nig = WGM * nN, gid = wgid / nig, fm = gid * WGM, gsz = (nM - fm) < WGM ? (nM - fm) : WGM;
        const int pm = fm + ((wgid % nig) % gsz), pn = (wgid % nig) / gsz;
        u.A = A + (size_t)pm * BM * lda * 2; u.B = B + (size_t)pn * BM * ldb * 2; u.out = out + ((size_t)pm * BM * ldc + (size_t)pn * BM) * esz; u.ldc = ldc; u.rows = nullptr; u.nvalid = BM; u.aux = pn; u.row0 = pm * BM;
        return true;
    }
};
struct MlaUpSched {
    const char* C1; const char* Wq; const char* Wkv; int G, c;
    DI bool next(int i, Unit& u) const {
        const int L = i * G + c; if (L >= 128 * 14) return false;
        const int pm = L / 14, idx = L % 14; const bool kv = idx >= 6; const int pn = kv ? idx - 6 : idx;
        u.A = C1 + ((size_t)pm * BM * MLA_INP + (kv ? 256 : 0)) * 2;
        u.B = (kv ? Wkv : Wq) + (size_t)pn * BM * 256 * 2;
        u.ldc = 0; u.out = nullptr; u.rows = nullptr; u.nvalid = BM; u.aux = idx; u.row0 = pm * BM;
        return true;
    }
};
struct CmpSched {
    const char* P; const char* W1T; char* HID; int nblk, c;
    DI bool next(int i, Unit& u) const {
        const int L = i * nblk + c; if (L >= 64) return false;
        const int rt = L & 1, g = (L >> 1) & 3, b = (L >> 3) & 3, kv = L >> 5;
        u.A = P + (((size_t)b * SEQ + (size_t)4096 * rt) * NSA_INP + (kv ? PC_VC : PC_KC) + 64 * g) * 2;
        u.B = W1T + (size_t)kv * 256 * 2048 * 2;
        u.out = HID + ((((size_t)kv * 4 + b) * 4 + g) * NCMPP + 256 * rt) * 128 * 2; u.ldc = 128; u.rows = nullptr; u.nvalid = BM; u.aux = kv; u.row0 = 0;
        return true;
    }
};
struct MoeSched {
    LAS const int* tstart; LAS const int* cnt; const int* rowlist; const char* A; const char* B; char* out; int npn, mode, G, c;
    DI bool next(int i, Unit& u) const {
        const int ntot = tstart[NEXP] * npn; const int L = i * G + c; if (L >= ntot) return false;
        const int ti = L / npn, pn = L % npn;
        int e = 0;
#pragma unroll 1
        for (int s = 32; s > 0; s >>= 1) { if (tstart[e + s] <= ti) e += s; }
        const int pm = ti - tstart[e];
        u.row0 = 0; u.rows = rowlist + (size_t)e * T + pm * BM; { const int left = cnt[e] - pm * BM; u.nvalid = left < BM ? left : BM; }
        if (mode == 1) { u.A = A; u.B = B + ((size_t)e * 512 + (size_t)pn * BM) * DM * 2; u.out = out + ((size_t)ti * BM * MOE_FF + (size_t)pn * HALF) * 2; u.ldc = MOE_FF; u.aux = 0; }
        else { u.A = A + (size_t)ti * BM * MOE_FF * 2; u.B = B + ((size_t)e * DM + (size_t)pn * BM) * MOE_FF * 2; u.out = out + ((size_t)e * T + pm * BM) * 4; u.ldc = DM; u.aux = pn * BM; }
        return true;
    }
};
}
struct Frame {
    LAS unsigned char* lds;
    unsigned char* ws;
    const float* const* in;
    int tid, lane, wave, G, bid, vcu;
    int cv_it, cv_end, cv_L;
};

DI int mla_invpos(int c) { const int w = c >> 5, fq = (c >> 3) & 3, h2 = (c >> 2) & 1, i = c & 3; return 32 * h2 + 4 * (4 * w + fq) + i; }
DI int srccol(int mode, int rho) {
    if (mode == 1) { if (rho < 1024) { const int head = 2 * (rho >> 8) + ((rho >> 7) & 1); return head * 192 + (rho & 127); }
                     const int q = rho - 1024; const int head = 4 * (q >> 8) + ((q >> 6) & 3); return head * 192 + 128 + mla_invpos(q & 63); }
    if (mode == 2) { if (rho < 512) return rho; if (rho < 576) return 512 + mla_invpos(rho - 512); return -1; }
    return rho;
}
DI void transpose_item(const float* src, int ld, int K, int nvalid, bf16_t* dst, const float* gain, LAS float* scr, int kb, int nb, int lane, int mode = 0) {
    const int k0 = 64 * kb, n0 = 32 * nb;
    const int nn = srccol(mode, n0 + (lane & 31)); const bool ok = nn >= 0 && nn < nvalid;
#pragma unroll 32
    for (int i = 0; i < 32; ++i) { const int kk = 2 * i + (lane >> 5); float v = ok ? src[(size_t)(k0 + kk) * ld + nn] : 0.f; if (gain) v *= gain[k0 + kk]; scr[kk * 33 + (lane & 31)] = v; }
    LDS_WAIT();
    const int c = lane & 7;
#pragma unroll
    for (int j = 0; j < 4; ++j) { const int n = (lane >> 3) + 8 * j; const LAS float* s = scr + (8 * c) * 33 + n;
        u32x4 o; o.x = pk2(s[0 * 33], s[1 * 33]); o.y = pk2(s[2 * 33], s[3 * 33]); o.z = pk2(s[4 * 33], s[5 * 33]); o.w = pk2(s[6 * 33], s[7 * 33]);
        *(u32x4*)(dst + (size_t)(n0 + n) * K + k0 + 8 * c) = o; }
    LDS_WAIT();
}

DI void prologue_phase(Frame& F) {
    LAS float* scr = (LAS float*)(F.lds + F.wave * 16384);
    const int gw = F.bid * NWAVES + F.wave, NGW = F.G * NWAVES, lane = F.lane;
    unsigned char* ws = F.ws;
    constexpr int I_A = 16 * 88, I_B = 16 * 32, I_C = 32 * 8, I_D = 16 * 24, I_E = 4 * 48, I_F = 4 * 64, I_G = 16 * 32;
    constexpr int PERJ = I_A + I_B + 2 * I_C + I_D + I_E + I_F + I_G;
    for (int it = gw; it < 2 * PERJ; it += NGW) {
        const int j = it / PERJ; int r = it % PERJ;
        if (r < I_A) { transpose_item(F.in[3] + (size_t)j * DM * NSA_IN, NSA_IN, DM, NSA_IN, (bf16_t*)(ws + WS_NSA_WIN) + (size_t)j * NSA_INP * DM, nullptr, scr, r / 88, r % 88, lane); continue; } r -= I_A;
        if (r < I_B) { transpose_item(F.in[9] + (size_t)j * DM * DM, DM, DM, DM, (bf16_t*)(ws + WS_NSA_WOUT) + (size_t)j * DM * DM, nullptr, scr, r / 32, r % 32, lane); continue; } r -= I_B;
        if (r < 2 * I_C) { const int kv = r / I_C; r %= I_C;
            transpose_item(F.in[5] + (size_t)(j * 2 + kv) * 2048 * 128, 128, 2048, 128, (bf16_t*)(ws + WS_CMP_W1T) + (size_t)(j * 2 + kv) * 256 * 2048, nullptr, scr, r / 8, r % 8, lane); continue; } r -= 2 * I_C;
        if (r < I_D) { transpose_item(F.in[10] + (size_t)j * DM * MLA_IN, MLA_IN, DM, MLA_IN, (bf16_t*)(ws + WS_MLA_WIN) + (size_t)j * MLA_INP * DM, nullptr, scr, r / 24, r % 24, lane, 2); continue; } r -= I_D;
        if (r < I_E) { transpose_item(F.in[13] + (size_t)j * 256 * 1536, 1536, 256, 1536, (bf16_t*)(ws + WS_MLA_WUQ) + (size_t)j * 1536 * 256, F.in[11] + j * 256, scr, r / 48, r % 48, lane, 1); continue; } r -= I_E;
        if (r < I_F) { transpose_item(F.in[14] + (size_t)j * 256 * 2048, 2048, 256, 2048, (bf16_t*)(ws + WS_MLA_WUKV) + (size_t)j * 2048 * 256, F.in[12] + j * 256, scr, r / 64, r % 64, lane); continue; } r -= I_F;
        transpose_item(F.in[19] + (size_t)j * DM * DM, DM, DM, DM, (bf16_t*)(ws + WS_MLA_WOUT) + (size_t)j * DM * DM, nullptr, scr, r / 32, r % 32, lane);
    }
    {
        float* ct = (float*)(ws + WS_ROPE); float* st = ct + SEQ * 32;
        const int gt = F.bid * NTHREADS + F.tid, NT_ = F.G * NTHREADS;
        for (int e = gt; e < SEQ * 32; e += NT_) { const int t = e >> 5, i = e & 31;
            const float inv = 1.0f / powf(10000.0f, (float)(2 * i) / 64.0f);
            const float ang = (float)t * inv;
            ct[e] = cosf(ang); st[e] = sinf(ang); }
        bf16_t* rwh = (bf16_t*)(ws + WS_RW); bf16_t* rwl = (bf16_t*)(ws + WS_RW + 1 * MiB);
        for (int e = gt; e < 4 * 96 * DM; e += NT_) { const int k = e & 1023, o = (e >> 10) % 96, L = e / (96 * DM);
            float w = 0.f;
            if (o < 8) w = F.in[20][((size_t)L * DM + k) * 8 + o]; else if (o < 72) w = F.in[22][((size_t)L * DM + k) * 64 + (o - 8)];
            w *= F.in[2][L * DM + k];
            const unsigned h = f2bf(w); const float rem = w - bf2f((unsigned short)h);
            const size_t d = (size_t)L * 96 * DM + ((size_t)((k >> 4) * 3 + (o >> 5)) * 64 + ((k >> 3) & 1) * 32 + (o & 31)) * 8 + (k & 7);
            rwh[d] = (bf16_t)h; rwl[d] = (bf16_t)f2bf(rem); }
        for (int u = F.bid; u < 64; u += F.G) { const int jk = u >> 4, h = F.tid & 127, q = F.tid >> 7, k0 = (u & 15) * 128 + q * 32;
            const float* pos = F.in[4] + (size_t)jk * 2048 + k0; const float* w1 = F.in[5] + ((size_t)jk * 2048 + k0) * 128 + h;
            float s = 0.f;
#pragma unroll 8
            for (int k = 0; k < 32; ++k) s += pos[k] * w1[(size_t)k * 128];
            ((float*)(ws + WS_CMPB + 512 * 1024))[(jk * 64 + (u & 15) * 4 + q) * 128 + h] = s; }
    }
}

DI void compress_bias_reduce(Frame& F) {
    for (int gw = F.bid * NWAVES + F.wave; gw < 512; gw += F.G * NWAVES) { const int jk = gw >> 7, h = gw & 127;
        const float v = wave_sum(((const float*)(F.ws + WS_CMPB + 512 * 1024))[(jk * 64 + F.lane) * 128 + h]);
        if (F.lane == 0) ((float*)(F.ws + WS_CMPB))[gw] = v; }
}

DI void glds16(const void* g, LAS void* l) { __builtin_amdgcn_global_load_lds((const unsigned*)g, (LAS unsigned*)l, 16, 0, 0); }
struct ConvItem { const float* src; bf16_t* dst; int ld, K; };
DI ConvItem moe_conv_item(const float* const* in, bf16_t* W1, bf16_t* W2, int L, int it) {
    const int e = it / 384; int r = it % 384; ConvItem c;
    if (r < 256) { const int up = r >> 7; r &= 127; const int kb = r >> 3, nb = r & 7, n0 = 32 * nb;
        c.src = in[up ? 25 : 24] + ((size_t)L * NEXP + e) * DM * MOE_FF + (size_t)(64 * kb) * MOE_FF + n0; c.ld = MOE_FF; c.K = DM;
        c.dst = W1 + ((size_t)e * 512 + 256 * (n0 >> 7) + 128 * up + (n0 & 127)) * DM + 64 * kb; }
    else { r -= 256; const int kb = r >> 5, nb = r & 31;
        c.src = in[26] + ((size_t)L * NEXP + e) * MOE_FF * DM + (size_t)(64 * kb) * DM + 32 * nb; c.ld = DM; c.K = MOE_FF;
        c.dst = W2 + (size_t)e * DM * MOE_FF + (size_t)(32 * nb) * MOE_FF + 64 * kb; }
    return c;
}
DI void conv_issue(const ConvItem& c, LAS unsigned char* scr, int lane) {
    const float* g = c.src + (size_t)(lane >> 3) * c.ld;
#pragma unroll
    for (int i = 0; i < 8; ++i) glds16(g + (size_t)(8 * i) * c.ld + 4 * (((lane & 7) - i) & 7), scr + i * 1024);
}
DI void conv_finish(const ConvItem& c, const LAS unsigned char* scr, int lane) {
    const int cc = lane & 7, nl = lane >> 3;
    const LAS float* sf = (const LAS float*)scr + cc * 256;
#pragma unroll
    for (int j = 0; j < 4; ++j) { const int n = nl + 8 * j; const LAS float* s = sf + ((((n >> 2) + cc) & 7) << 2) + (n & 3);
        u32x4 o; o.x = pk2(s[0], s[32]); o.y = pk2(s[64], s[96]); o.z = pk2(s[128], s[160]); o.w = pk2(s[192], s[224]);
        *(u32x4*)(c.dst + (size_t)n * c.K + 8 * cc) = o; }
}
constexpr int CONV_NIT = NEXP * 384;
DI ConvItem conv_item2(const float* const* in, unsigned char* ws, int Lb, int it) {
    const bool second = it >= CONV_NIT;
    return moe_conv_item(in, (bf16_t*)(ws + (second ? WS_MOE_W1B : WS_MOE_W1)), (bf16_t*)(ws + (second ? WS_MOE_W2B : WS_MOE_W2)), Lb + (second ? 1 : 0), second ? it - CONV_NIT : it);
}

constexpr int XLD = 2 * DM;
DI void norm_phase(Frame& F, const float* xf32, const bf16_t* xsrc, bf16_t* xdst, const bf16_t* y2, const float* g, bf16_t* h) {
    const int gw = F.bid * NWAVES + F.wave, NGW = F.G * NWAVES, lane = F.lane;
    f32x4 gv[4];
#pragma unroll
    for (int j = 0; j < 4; ++j) gv[j] = g ? *(const f32x4*)(g + 4 * lane + 256 * j) : (f32x4){1.f, 1.f, 1.f, 1.f};
#pragma unroll 2
    for (int row = gw; row < T; row += NGW) {
        f32x4 v[4];
        if (xf32) { const f32x4* xr = (const f32x4*)(xf32 + (size_t)row * DM) + lane;
#pragma unroll
            for (int j = 0; j < 4; ++j) v[j] = xr[64 * j];
        } else { const u32x2* xr = (const u32x2*)(xsrc + (size_t)row * XLD) + lane;
#pragma unroll
            for (int j = 0; j < 4; ++j) { const u32x2 a = xr[64 * j]; v[j][0] = bflo(a.x); v[j][1] = bfhi(a.x); v[j][2] = bflo(a.y); v[j][3] = bfhi(a.y); } }
        if (y2) {
            const u32x2* y0 = (const u32x2*)(y2 + (size_t)row * 2 * DM) + lane; const u32x2* y1 = y0 + DM / 4;
#pragma unroll
            for (int j = 0; j < 4; ++j) { const u32x2 a = y0[64 * j], b = y1[64 * j];
                v[j][0] += bflo(a.x) + bflo(b.x); v[j][1] += bfhi(a.x) + bfhi(b.x); v[j][2] += bflo(a.y) + bflo(b.y); v[j][3] += bfhi(a.y) + bfhi(b.y); }
        }
        u32x2* xo = (u32x2*)(xdst + (size_t)row * XLD) + lane;
#pragma unroll
        for (int j = 0; j < 4; ++j) { u32x2 o; o.x = pk2(v[j][0], v[j][1]); o.y = pk2(v[j][2], v[j][3]); xo[64 * j] = o; }
        if (h) {
            float ss = 0.f;
#pragma unroll
            for (int j = 0; j < 4; ++j) ss += (v[j][0] * v[j][0] + v[j][1] * v[j][1]) + (v[j][2] * v[j][2] + v[j][3] * v[j][3]);
            ss = wave_sum(ss);
            const float rstd = 1.0f / sqrtf(ss * (1.0f / DM) + RMS_EPS);
            u32x2* ho = (u32x2*)(h + (size_t)row * DM) + lane;
#pragma unroll
            for (int j = 0; j < 4; ++j) { u32x2 o; o.x = pk2(v[j][0] * rstd * gv[j][0], v[j][1] * rstd * gv[j][1]); o.y = pk2(v[j][2] * rstd * gv[j][2], v[j][3] * rstd * gv[j][3]); ho[64 * j] = o; }
        }
    }
}
DI void final_phase(Frame& F, float* out, const bf16_t* y2) {
    const int gw = F.bid * NWAVES + F.wave, NGW = F.G * NWAVES, lane = F.lane;
#pragma unroll 1
    for (int row = gw; row < T; row += NGW) {
        f32x4 v[4];
        const u32x2* xr = (const u32x2*)((const bf16_t*)out + (size_t)row * XLD + DM) + lane;
        const u32x2* y0 = (const u32x2*)(y2 + (size_t)row * 2 * DM) + lane; const u32x2* y1 = y0 + DM / 4;
        u32x2 xa[4], ya[4], yb[4];
#pragma unroll
        for (int j = 0; j < 4; ++j) { xa[j] = xr[64 * j]; ya[j] = y0[64 * j]; yb[j] = y1[64 * j]; }
        asm volatile("s_waitcnt vmcnt(0)" ::: "memory");
        __builtin_amdgcn_sched_barrier(0);
#pragma unroll
        for (int j = 0; j < 4; ++j) { v[j][0] = bflo(xa[j].x) + (bflo(ya[j].x) + bflo(yb[j].x)); v[j][1] = bfhi(xa[j].x) + (bfhi(ya[j].x) + bfhi(yb[j].x));
            v[j][2] = bflo(xa[j].y) + (bflo(ya[j].y) + bflo(yb[j].y)); v[j][3] = bfhi(xa[j].y) + (bfhi(ya[j].y) + bfhi(yb[j].y)); }
        f32x4* xo = (f32x4*)(out + (size_t)row * DM) + lane;
#pragma unroll
        for (int j = 0; j < 4; ++j) xo[64 * j] = v[j];
    }
}

DI void unpack8(const u32x4& w, float* f) { f[0] = bflo(w.x); f[1] = bfhi(w.x); f[2] = bflo(w.y); f[3] = bfhi(w.y); f[4] = bflo(w.z); f[5] = bfhi(w.z); f[6] = bflo(w.w); f[7] = bfhi(w.w); }
DI u32x4 pack8f(const float* f) { u32x4 w; w.x = pk2(f[0], f[1]); w.y = pk2(f[2], f[3]); w.z = pk2(f[4], f[5]); w.w = pk2(f[6], f[7]); return w; }
DI void nsa_post_phase(Frame& F, int j, int gw, int NGW) {
    const int lane = F.lane;
    const bf16_t* P = (const bf16_t*)(F.ws + WS_PBUF);
    bf16_t* Q = (bf16_t*)(F.ws + WS_QA); bf16_t* QR = Q + (size_t)T * DM; bf16_t* KS = QR + (size_t)T * DM; bf16_t* KW = KS + (size_t)T * 256;
    const float* ct = (const float*)(F.ws + WS_ROPE); const float* st = ct + SEQ * 32;
    const int c = lane & 3, hd = lane >> 2;
    float gq1[8], gq2[8], gk1[8], gk2[8];
    {
        const float* gq = F.in[7] + j * 64;
#pragma unroll
        for (int i = 0; i < 8; ++i) { gq1[i] = gq[8 * c + i]; gq2[i] = gq[32 + 8 * c + i]; }
        const float* gk = F.in[8] + (j * 3 + ((lane >> 4) & 1) + 1) * 64;
#pragma unroll
        for (int i = 0; i < 8; ++i) { gk1[i] = gk[8 * c + i]; gk2[i] = gk[32 + 8 * c + i]; }
    }
#pragma unroll 2
    for (int row = gw; row < T; row += NGW) {
        const bf16_t* pr = P + (size_t)row * NSA_INP;
        const int t = row & (SEQ - 1);
        float cs[8], sn[8];
        { const f32x4 c0 = *(const f32x4*)(ct + t * 32 + 8 * c), c1 = *(const f32x4*)(ct + t * 32 + 8 * c + 4), s0 = *(const f32x4*)(st + t * 32 + 8 * c), s1 = *(const f32x4*)(st + t * 32 + 8 * c + 4);
#pragma unroll
          for (int i = 0; i < 4; ++i) { cs[i] = c0[i]; cs[4 + i] = c1[i]; sn[i] = s0[i]; sn[4 + i] = s1[i]; } }
        {
            float a[8], b[8];
            unpack8(*(const u32x4*)(pr + hd * 64 + 8 * c), a); unpack8(*(const u32x4*)(pr + hd * 64 + 32 + 8 * c), b);
            float ss = 0.f;
#pragma unroll
            for (int i = 0; i < 8; ++i) ss += a[i] * a[i] + b[i] * b[i];
            ss += shx(ss, 1); ss += shx(ss, 2);
            const float rstd = 1.0f / sqrtf(ss * (1.0f / 64.0f) + RMS_EPS);
            float o1[8], o2[8];
#pragma unroll
            for (int i = 0; i < 8; ++i) { const float x1 = a[i] * rstd * gq1[i], x2 = b[i] * rstd * gq2[i]; o1[i] = x1 * NSA_QS; o2[i] = x2 * NSA_QS; }
            *(u32x4*)(Q + (size_t)row * DM + hd * 64 + 8 * c) = pack8f(o1); *(u32x4*)(Q + (size_t)row * DM + hd * 64 + 32 + 8 * c) = pack8f(o2);
        }
        if (lane < 32) {
            const int grp = hd & 3; const bool win = lane >= 16;
            const bf16_t* kp = pr + (win ? PC_KW : PC_KS) + grp * 64;
            float a[8], b[8];
            unpack8(*(const u32x4*)(kp + 8 * c), a); unpack8(*(const u32x4*)(kp + 32 + 8 * c), b);
            float ss = 0.f;
#pragma unroll
            for (int i = 0; i < 8; ++i) ss += a[i] * a[i] + b[i] * b[i];
            ss += shx(ss, 1); ss += shx(ss, 2);
            const float rstd = 1.0f / sqrtf(ss * (1.0f / 64.0f) + RMS_EPS);
            float r1[8], r2[8];
#pragma unroll
            for (int i = 0; i < 8; ++i) { const float x1 = a[i] * rstd * gk1[i], x2 = b[i] * rstd * gk2[i]; r1[i] = x1 * cs[i] - x2 * sn[i]; r2[i] = x2 * cs[i] + x1 * sn[i]; }
            bf16_t* ko = (win ? KW : KS) + (size_t)row * 256 + grp * 64;
            *(u32x4*)(ko + 8 * c) = pack8f(r1); *(u32x4*)(ko + 32 + 8 * c) = pack8f(r2);
        }
    }
}

DI void cmp2_phase(Frame& F, int j) {
    const int gw = F.bid * NWAVES + F.wave, NGW = F.G * NWAVES, lane = F.lane;
    const bf16_t* HID = (const bf16_t*)(F.ws + WS_HID);
    bf16_t* KC = (bf16_t*)(F.ws + WS_KCMP); bf16_t* VC = (bf16_t*)(F.ws + WS_VCMP);
    const float gk = F.in[8][(j * 3 + 0) * 64 + lane];
    float w2r[128]; int curkv = -1;
#pragma unroll 1
    for (int row = gw; row < 2 * 16 * NCMPP; row += NGW) {
        const int n = row & 511, g = (row >> 9) & 3, b = (row >> 11) & 3, kv = row >> 13;
        if (kv != curkv) { const float* w2 = F.in[6] + (size_t)(j * 2 + kv) * 128 * 64 + lane;
#pragma unroll
            for (int h = 0; h < 128; ++h) w2r[h] = w2[(size_t)h * 64];
            curkv = kv; }
        const u32x4* hr = (const u32x4*)(HID + (size_t)row * 128);
        u32x4 hq[16];
#pragma unroll
        for (int h8 = 0; h8 < 16; ++h8) hq[h8] = hr[h8];
        float a0 = 0.f, a1 = 0.f, a2 = 0.f, a3 = 0.f;
#pragma unroll
        for (int h8 = 0; h8 < 16; ++h8) { float hv[8]; unpack8(hq[h8], hv);
            a0 += hv[0] * w2r[8 * h8] + hv[4] * w2r[8 * h8 + 4]; a1 += hv[1] * w2r[8 * h8 + 1] + hv[5] * w2r[8 * h8 + 5];
            a2 += hv[2] * w2r[8 * h8 + 2] + hv[6] * w2r[8 * h8 + 6]; a3 += hv[3] * w2r[8 * h8 + 3] + hv[7] * w2r[8 * h8 + 7]; }
        const float acc = (a0 + a1) + (a2 + a3);
        float o = acc;
        if (kv == 0) { const float ss = wave_sum(acc * acc); o = acc * (1.0f / sqrtf(ss * (1.0f / 64.0f) + RMS_EPS)) * gk; }
        if (n >= NCMP) o = 0.f;
        bf16_t* dst = (kv ? VC : KC) + (((size_t)b * NCMPP + n) * 4 + g) * 64 + lane;
        *dst = (bf16_t)f2bf(o);
    }
}

DI void mla_post_phase(Frame& F, int j) {
    const int gw = F.bid * NWAVES + F.wave, NGW = F.G * NWAVES, lane = F.lane;
    const bf16_t* C1 = (const bf16_t*)(F.ws + WS_PBUF); const bf16_t* Qraw = C1 + (size_t)T * MLA_INP; const bf16_t* KVraw = Qraw + (size_t)T * 1536;
    bf16_t* Qf = (bf16_t*)(F.ws + WS_QA); bf16_t* Kf = Qf + (size_t)T * 1536; bf16_t* Vf = Kf + (size_t)T * 1536;
    const float* ct = (const float*)(F.ws + WS_ROPE); const float* st = ct + SEQ * 32;
    const int h = lane >> 3, c8 = lane & 7;
    float gqn[16], gkn[16], gqr1[4], gqr2[4], gkr1[4], gkr2[4];
#pragma unroll
    for (int i = 0; i < 16; ++i) { gqn[i] = F.in[15][j * 128 + 16 * c8 + i]; gkn[i] = F.in[17][j * 128 + 16 * c8 + i]; }
#pragma unroll
    for (int i = 0; i < 4; ++i) { gqr1[i] = F.in[16][j * 64 + 4 * c8 + i]; gqr2[i] = F.in[16][j * 64 + 32 + 4 * c8 + i]; gkr1[i] = F.in[18][j * 64 + 4 * c8 + i]; gkr2[i] = F.in[18][j * 64 + 32 + 4 * c8 + i]; }
#pragma unroll 2
    for (int row = gw; row < T; row += NGW) {
        const int t = row & (SEQ - 1);
        const bf16_t* c1 = C1 + (size_t)row * MLA_INP;
        float rq, rkv;
        { const u32x2 a = *(const u32x2*)(c1 + 4 * lane), b = *(const u32x2*)(c1 + 256 + 4 * lane);
          float sq = bflo(a.x) * bflo(a.x) + bfhi(a.x) * bfhi(a.x) + bflo(a.y) * bflo(a.y) + bfhi(a.y) * bfhi(a.y);
          float sk = bflo(b.x) * bflo(b.x) + bfhi(b.x) * bfhi(b.x) + bflo(b.y) * bflo(b.y) + bfhi(b.y) * bfhi(b.y);
          sq = wave_sum(sq); sk = wave_sum(sk);
          rq = 1.0f / sqrtf(sq * (1.0f / 256.0f) + RMS_EPS); rkv = 1.0f / sqrtf(sk * (1.0f / 256.0f) + RMS_EPS); }
        float cs[4], sn[4];
        { const f32x4 c0 = *(const f32x4*)(ct + t * 32 + 4 * c8), s0 = *(const f32x4*)(st + t * 32 + 4 * c8);
#pragma unroll
          for (int i = 0; i < 4; ++i) { cs[i] = c0[i]; sn[i] = s0[i]; } }
        {
            const bf16_t* qp = Qraw + (size_t)row * 1536 + h * 192;
            float a[16]; unpack8(*(const u32x4*)(qp + 16 * c8), a); unpack8(*(const u32x4*)(qp + 16 * c8 + 8), a + 8);
            float ss = 0.f;
#pragma unroll
            for (int i = 0; i < 16; ++i) { a[i] *= rq; ss += a[i] * a[i]; }
            ss += shx(ss, 1); ss += shx(ss, 2); ss += shx(ss, 4);
            const float rs = 1.0f / sqrtf(ss * (1.0f / 128.0f) + RMS_EPS) * MLA_QS;
#pragma unroll
            for (int i = 0; i < 16; ++i) a[i] = a[i] * rs * gqn[i];
            bf16_t* qo = Qf + (size_t)row * 1536 + h * 192;
            *(u32x4*)(qo + 16 * c8) = pack8f(a); *(u32x4*)(qo + 16 * c8 + 8) = pack8f(a + 8);
            const u32x2 r1 = *(const u32x2*)(qp + 128 + 4 * c8), r2 = *(const u32x2*)(qp + 160 + 4 * c8);
            float x1[4] = {bflo(r1.x) * rq, bfhi(r1.x) * rq, bflo(r1.y) * rq, bfhi(r1.y) * rq}, x2[4] = {bflo(r2.x) * rq, bfhi(r2.x) * rq, bflo(r2.y) * rq, bfhi(r2.y) * rq};
            float s2 = 0.f;
#pragma unroll
            for (int i = 0; i < 4; ++i) s2 += x1[i] * x1[i] + x2[i] * x2[i];
            s2 += shx(s2, 1); s2 += shx(s2, 2); s2 += shx(s2, 4);
            const float rr = 1.0f / sqrtf(s2 * (1.0f / 64.0f) + RMS_EPS) * MLA_QS;
            float o1[4], o2[4];
#pragma unroll
            for (int i = 0; i < 4; ++i) { const float y1 = x1[i] * rr * gqr1[i], y2 = x2[i] * rr * gqr2[i]; o1[i] = y1 * cs[i] - y2 * sn[i]; o2[i] = y2 * cs[i] + y1 * sn[i]; }
            u32x2 w1, w2; w1.x = pk2(o1[0], o1[1]); w1.y = pk2(o1[2], o1[3]); w2.x = pk2(o2[0], o2[1]); w2.y = pk2(o2[2], o2[3]);
            *(u32x2*)(qo + 128 + 4 * c8) = w1; *(u32x2*)(qo + 160 + 4 * c8) = w2;
        }
        u32x2 kr1, kr2;
        {
            const u32x2 r1 = *(const u32x2*)(c1 + 512 + 4 * c8), r2 = *(const u32x2*)(c1 + 544 + 4 * c8);
            float x1[4] = {bflo(r1.x), bfhi(r1.x), bflo(r1.y), bfhi(r1.y)}, x2[4] = {bflo(r2.x), bfhi(r2.x), bflo(r2.y), bfhi(r2.y)};
            float s2 = 0.f;
#pragma unroll
            for (int i = 0; i < 4; ++i) s2 += x1[i] * x1[i] + x2[i] * x2[i];
            s2 += shx(s2, 1); s2 += shx(s2, 2); s2 += shx(s2, 4);
            const float rr = 1.0f / sqrtf(s2 * (1.0f / 64.0f) + RMS_EPS);
            float o1[4], o2[4];
#pragma unroll
            for (int i = 0; i < 4; ++i) { const float y1 = x1[i] * rr * gkr1[i], y2 = x2[i] * rr * gkr2[i]; o1[i] = y1 * cs[i] - y2 * sn[i]; o2[i] = y2 * cs[i] + y1 * sn[i]; }
            kr1.x = pk2(o1[0], o1[1]); kr1.y = pk2(o1[2], o1[3]); kr2.x = pk2(o2[0], o2[1]); kr2.y = pk2(o2[2], o2[3]);
        }
        {
            const bf16_t* kp = KVraw + (size_t)row * 2048 + h * 256;
            float a[16]; unpack8(*(const u32x4*)(kp + 16 * c8), a); unpack8(*(const u32x4*)(kp + 16 * c8 + 8), a + 8);
            float ss = 0.f;
#pragma unroll
            for (int i = 0; i < 16; ++i) { a[i] *= rkv; ss += a[i] * a[i]; }
            ss += shx(ss, 1); ss += shx(ss, 2); ss += shx(ss, 4);
            const float rs = 1.0f / sqrtf(ss * (1.0f / 128.0f) + RMS_EPS);
#pragma unroll
            for (int i = 0; i < 16; ++i) a[i] = a[i] * rs * gkn[i];
            bf16_t* ko = Kf + (size_t)row * 1536 + h * 192;
            *(u32x4*)(ko + 16 * c8) = pack8f(a); *(u32x4*)(ko + 16 * c8 + 8) = pack8f(a + 8);
            *(u32x2*)(ko + 128 + 4 * c8) = kr1; *(u32x2*)(ko + 160 + 4 * c8) = kr2;
            float v[16]; unpack8(*(const u32x4*)(kp + 128 + 16 * c8), v); unpack8(*(const u32x4*)(kp + 128 + 16 * c8 + 8), v + 8);
#pragma unroll
            for (int i = 0; i < 16; ++i) v[i] *= rkv;
            bf16_t* vo = Vf + (size_t)row * DM + h * 128;
            *(u32x4*)(vo + 16 * c8) = pack8f(v); *(u32x4*)(vo + 16 * c8 + 8) = pack8f(v + 8);
        }
    }
}
DI f32x16 zero16() { const f32x16 z = {0.f, 0.f, 0.f, 0.f, 0.f, 0.f, 0.f, 0.f, 0.f, 0.f, 0.f, 0.f, 0.f, 0.f, 0.f, 0.f}; return z; }
DI float partner32(float v, int hi) { auto rr = __builtin_amdgcn_permlane32_swap(__float_as_uint(v), __float_as_uint(v), false, false); return hi ? __uint_as_float(rr[0]) : __uint_as_float(rr[1]); }
#define MFMA32(a, b, c) __builtin_amdgcn_mfma_f32_32x32x16_bf16((a), (b), (c), 0, 0, 0)
constexpr size_t WS_LLIST = WS_ROUTE + 1 * MiB, WS_HIST = WS_ROUTE + 2 * MiB, WS_TOT = WS_ROUTE + 3 * MiB;
constexpr size_t WS_RWH = WS_RW, WS_RWL = WS_RW + 1 * MiB;
DI void router_phase(Frame& F, int L, const bf16_t* x, bf16_t* h2, bool commit) {
    LAS float* lg = (LAS float*)F.lds;
    LAS float* rs = (LAS float*)(F.lds + 60 * 1024);
    LAS int* lcnt = (LAS int*)(F.lds + 62 * 1024);
    const int tid = F.tid, lane = F.lane, wave = F.wave, r32 = lane & 31, hi = lane >> 5;
    const bf16_t* wh = (const bf16_t*)(F.ws + WS_RWH) + (size_t)L * 96 * DM; const bf16_t* wl = (const bf16_t*)(F.ws + WS_RWL) + (size_t)L * 96 * DM;
    int* llist = (int*)(F.ws + WS_LLIST); int* hist = (int*)(F.ws + WS_HIST); float* wts = (float*)(F.ws + WS_ROUTE);
    for (int unit = F.bid; unit < T / 128; unit += F.G) {
        const int tok0 = unit * 128;
        if (tid < 64) lcnt[tid] = 0;
        {
            const int rg = wave & 3, kh = wave >> 2;
            f32x16 acc[3]; acc[0] = zero16(); acc[1] = zero16(); acc[2] = zero16();
            float ss = 0.f;
            const char* xb = (const char*)(x + (size_t)(tok0 + 32 * rg + (lane >> 2)) * XLD + 512 * kh) + (lane & 3) * 16;
            LAS unsigned char* stg = F.lds + 131072 + wave * 2048;
            const int wofs = (lane >> 2) * 64 + (((lane & 3) + (lane >> 4)) & 3) * 16;
            const int ra = r32 * 64 + ((hi + (r32 >> 2)) & 3) * 16, rb = r32 * 64 + ((2 + hi + (r32 >> 2)) & 3) * 16;
            const bf16_t* whp = wh + ((size_t)(32 * kh) * 3 * 64 + lane) * 8;
            u32x4 xbuf[2][2];
#pragma unroll
            for (int i = 0; i < 2; ++i) { xbuf[i][0] = *(const GAS u32x4*)(xb + i * 64); xbuf[i][1] = *(const GAS u32x4*)(xb + (size_t)16 * XLD * 2 + i * 64); }
#pragma unroll 1
            for (int sb = 0; sb < 8; ++sb) {
                u32x4 xf[4]; bf16x8 ah[4][3];
#pragma unroll
                for (int i = 0; i < 4; ++i)
#pragma unroll
                    for (int t = 0; t < 3; ++t) ah[i][t] = *(const GAS bf16x8*)(whp + (size_t)((4 * sb + i) * 3 + t) * 512);
                __builtin_amdgcn_sched_barrier(0);
#pragma unroll
                for (int i = 0; i < 2; ++i) { *(LAS u32x4*)(stg + wofs) = xbuf[i][0]; *(LAS u32x4*)(stg + wofs + 1024) = xbuf[i][1];
                    xf[2 * i] = *(const LAS u32x4*)(stg + ra); xf[2 * i + 1] = *(const LAS u32x4*)(stg + rb); }
                __builtin_amdgcn_sched_barrier(0);
#pragma unroll
                for (int i = 0; i < 4; ++i) {
                    const u32x4 xw = xf[i];
                    ss += (bflo(xw.x) * bflo(xw.x) + bfhi(xw.x) * bfhi(xw.x)) + (bflo(xw.y) * bflo(xw.y) + bfhi(xw.y) * bfhi(xw.y))
                        + (bflo(xw.z) * bflo(xw.z) + bfhi(xw.z) * bfhi(xw.z)) + (bflo(xw.w) * bflo(xw.w) + bfhi(xw.w) * bfhi(xw.w));
                    const bf16x8 bh = __builtin_bit_cast(bf16x8, xw);
#pragma unroll
                    for (int t = 0; t < 3; ++t) acc[t] = MFMA32(ah[i][t], bh, acc[t]);
                    if (i == 0) {
                        __builtin_amdgcn_sched_barrier(0);
                        if (sb < 7) {
#pragma unroll
                            for (int q = 0; q < 2; ++q) { xbuf[q][0] = *(const GAS u32x4*)(xb + (2 * (sb + 1) + q) * 64); xbuf[q][1] = *(const GAS u32x4*)(xb + (size_t)16 * XLD * 2 + (2 * (sb + 1) + q) * 64); } }
                        __builtin_amdgcn_sched_barrier(0); }
                }
            }
            LAS float* part = (LAS float*)(F.lds + 64 * 1024) + (rg * 64 + lane) * 49;
            if (kh == 1) {
#pragma unroll
                for (int t = 0; t < 3; ++t)
#pragma unroll
                    for (int r = 0; r < 16; ++r) part[t * 16 + r] = acc[t][r];
                part[48] = ss;
            }
            __syncthreads();
            if (kh == 0) {
#pragma unroll
                for (int t = 0; t < 3; ++t)
#pragma unroll
                    for (int r = 0; r < 16; ++r) acc[t][r] += part[t * 16 + r];
                ss += part[48];
                ss += partner32(ss, hi);
                const float rstd = 1.0f / sqrtf(ss * (1.0f / DM) + RMS_EPS);
                const int r32b = opq(lane) & 31;
                if (hi == 0) rs[32 * rg + r32b] = rstd;
                LAS float* lrow = lg + (32 * rg + r32b) * 100;
#pragma unroll
                for (int t = 0; t < 3; ++t)
#pragma unroll
                    for (int g4 = 0; g4 < 4; ++g4) { f32x4 v; v[0] = acc[t][4 * g4] * rstd; v[1] = acc[t][4 * g4 + 1] * rstd; v[2] = acc[t][4 * g4 + 2] * rstd; v[3] = acc[t][4 * g4 + 3] * rstd;
                        *(LAS f32x4*)(lrow + 32 * t + 8 * g4 + 4 * hi) = v; }
            }
        }
        __syncthreads();
        if (tid < 128) {
            const LAS float* l = lg + tid * 100;
            float gl[8];
#pragma unroll
            for (int i = 0; i < 8; ++i) gl[i] = l[i] + F.in[21][L * 8 + i];
            float gmax = gl[0]; int grp = 0;
#pragma unroll
            for (int i = 1; i < 8; ++i) { if (gl[i] > gmax) { gmax = gl[i]; grp = i; } }
            float gsum = 0.f;
#pragma unroll
            for (int i = 0; i < 8; ++i) gsum += __expf(gl[i] - gmax);
            const float gw_ = 1.0f / gsum;
            const LAS float* el = l + 8 + grp * 8; const float* eb = F.in[23] + L * 64 + grp * 8;
            float ev[8];
#pragma unroll
            for (int i = 0; i < 8; ++i) ev[i] = el[i] + eb[i];
            float b1 = ev[0]; int i1 = 0;
#pragma unroll
            for (int i = 1; i < 8; ++i) { if (ev[i] > b1) { b1 = ev[i]; i1 = i; } }
            float b2 = -3.0e38f; int i2 = 0;
#pragma unroll
            for (int i = 0; i < 8; ++i) { if (i != i1 && ev[i] > b2) { b2 = ev[i]; i2 = i; } }
            const float e2 = __expf(b2 - b1);
            const float w1 = gw_ / (1.0f + e2), w2 = gw_ * e2 / (1.0f + e2);
            const int tok = tok0 + tid; const int ex1 = grp * 8 + i1, ex2 = grp * 8 + i2;
            if (commit) { const int k1 = __hip_atomic_fetch_add(lcnt + ex1, 1, __ATOMIC_RELAXED, __HIP_MEMORY_SCOPE_WORKGROUP), k2 = __hip_atomic_fetch_add(lcnt + ex2, 1, __ATOMIC_RELAXED, __HIP_MEMORY_SCOPE_WORKGROUP);
                llist[2 * tok] = ex1 | (k1 << 8); llist[2 * tok + 1] = ex2 | (k2 << 8);
                wts[2 * tok] = w1; wts[2 * tok + 1] = w2; }
        }
        __syncthreads();
        if (commit && tid < 64) hist[unit * 64 + tid] = lcnt[tid];
        {
            const float* g = F.in[2] + L * DM;
            f32x4 gv[4];
#pragma unroll
            for (int j = 0; j < 4; ++j) gv[j] = *(const f32x4*)(g + 4 * lane + 256 * j);
#pragma unroll 1
            for (int r = 0; r < 16; r += 4) {
                f32x4 v[4][4];
#pragma unroll
                for (int q = 0; q < 4; ++q) { const u32x2* xr2 = (const u32x2*)(x + (size_t)(tok0 + 16 * wave + r + q) * XLD) + lane;
#pragma unroll
                    for (int j = 0; j < 4; ++j) { const u32x2 a = xr2[64 * j]; v[q][j][0] = bflo(a.x); v[q][j][1] = bfhi(a.x); v[q][j][2] = bflo(a.y); v[q][j][3] = bfhi(a.y); } }
#pragma unroll
                for (int q = 0; q < 4; ++q) { const int row = 16 * wave + r + q; const float rstd = rs[row];
                    u32x2* ho = (u32x2*)(h2 + (size_t)(tok0 + row) * DM) + lane;
#pragma unroll
                    for (int j = 0; j < 4; ++j) { u32x2 o; o.x = pk2(v[q][j][0] * rstd * gv[j][0], v[q][j][1] * rstd * gv[j][1]); o.y = pk2(v[q][j][2] * rstd * gv[j][2], v[q][j][3] * rstd * gv[j][3]); ho[64 * j] = o; } }
            }
        }
        __syncthreads();
    }
}
DI void moe_scatter_phase(Frame& F) {
    LAS int* ps = (LAS int*)F.lds;
    const int tid = F.tid;
    const int* llist = (const int*)(F.ws + WS_LLIST); const int* hist = (const int*)(F.ws + WS_HIST); int* rowlist = (int*)(F.ws + WS_ROWLIST); int* tot = (int*)(F.ws + WS_TOT);
    float* roww = (float*)(F.ws + WS_ROWW); const float* wts = (const float*)(F.ws + WS_ROUTE);
    for (int unit = F.bid; unit < T / 128; unit += F.G) {
        __syncthreads();
        { const int e = tid & 63, part = tid >> 6; int s = 0, t = 0;
          for (int u = part * 32; u < part * 32 + 32; ++u) { const int h = hist[u * 64 + e]; t += h; if (u < unit) s += h; }
          ps[part * 64 + e] = s; ps[512 + part * 64 + e] = t; }
        __syncthreads();
        if (tid < 64) { int s = 0, t = 0;
#pragma unroll
            for (int p = 0; p < 8; ++p) { s += ps[p * 64 + tid]; t += ps[512 + p * 64 + tid]; }
            ps[1024 + tid] = s; if (unit == 0) tot[tid] = t; }
        __syncthreads();
        if (tid < 256) { const int a = 2 * (unit * 128) + tid; const int v = llist[a]; const int e = v & 255, rk = v >> 8;
            const size_t pos = (size_t)e * T + ps[1024 + e] + rk; rowlist[pos] = a; roww[pos] = wts[a]; }
    }
}

struct KSrc { const bf16_t* p; const bf16_t* p2; };
template <int DQK> DI void dma_k(KSrc ks, int pitch, LAS unsigned char* dst, int wave, int lane) {
#pragma unroll
    for (int c = 0; c < DQK / 64; ++c) { const int ch = wave + 8 * c;
        if (DQK == 192 && c == 2) glds16(ks.p2 + (size_t)lane * 64 + (ch - 16) * 8, dst + ch * 1024);
        else glds16(ks.p + (size_t)lane * pitch + ch * 8, dst + ch * 1024); }
}
template <int DV> DI void dma_v(const bf16_t* vbase, int pitch, LAS unsigned char* dst, int wave, int lane) {
#pragma unroll
    for (int c = 0; c < DV / 64; ++c) { const int blk = wave + 8 * c, d0 = blk >> 2, ks = blk & 3;
        glds16(vbase + (size_t)(16 * ks + (lane >> 2)) * pitch + d0 * 32 + (lane & 3) * 8, dst + blk * 1024); }
}
DI int crow(int r, int hi) { return (r & 3) + 8 * (r >> 2) + 4 * hi; }
#ifndef ATT_VAR
#define ATT_VAR 0
#endif
#define NEG_INF_F (-__builtin_inff())
template <int DQK> DI void qk_tile(f32x16& p0, f32x16& p1, const LAS unsigned char* Kb, const bf16x8* qf, int r32, int hi, int var = 0, const f32x16* cinit = nullptr) {
    if (var & 4) { const float c = 0.01f * r32; for (int r = 0; r < 16; ++r) { p0[r] = c; p1[r] = c; } return; }
    const unsigned kb = (unsigned)(size_t)Kb + hi * 1024 + r32 * 16;
    const f32x16 z = {0.f, 0.f, 0.f, 0.f, 0.f, 0.f, 0.f, 0.f, 0.f, 0.f, 0.f, 0.f, 0.f, 0.f, 0.f, 0.f};
    if (cinit) { p0 = *cinit; p1 = *cinit; } else { p0 = z; p1 = z; }
#pragma unroll
    for (int g = 0; g < DQK / 64; ++g) {
        bf16x8 k0[4], k1[4];
#pragma unroll
        for (int i = 0; i < 4; ++i) {
            asm volatile("ds_read_b128 %0, %1 offset:%c2" : "=&v"(k0[i]) : "v"(kb), "i"((4 * g + i) * 2048) : "memory");
            asm volatile("ds_read_b128 %0, %1 offset:%c2" : "=&v"(k1[i]) : "v"(kb), "i"((4 * g + i) * 2048 + 512) : "memory"); }
        asm volatile("s_waitcnt lgkmcnt(0)" ::: "memory"); __builtin_amdgcn_sched_barrier(0);
#pragma unroll
        for (int i = 0; i < 4; ++i) { p0 = MFMA32(k0[i], qf[4 * g + i], p0); p1 = MFMA32(k1[i], qf[4 * g + i], p1); }
    }
}
DI float rowmax32(const f32x16& p0, const f32x16& p1) {
    float a0 = fmaxf(p0[0], p1[0]), a1 = fmaxf(p0[1], p1[1]), a2 = fmaxf(p0[2], p1[2]), a3 = fmaxf(p0[3], p1[3]);
#pragma unroll
    for (int r = 4; r < 16; r += 4) { a0 = fmaxf(a0, fmaxf(p0[r], p1[r])); a1 = fmaxf(a1, fmaxf(p0[r + 1], p1[r + 1])); a2 = fmaxf(a2, fmaxf(p0[r + 2], p1[r + 2])); a3 = fmaxf(a3, fmaxf(p0[r + 3], p1[r + 3])); }
    const float a = fmaxf(fmaxf(a0, a1), fmaxf(a2, a3));
    auto rr = __builtin_amdgcn_permlane32_swap(__float_as_uint(a), __float_as_uint(a), false, false);
    return fmaxf(__uint_as_float(rr[0]), __uint_as_float(rr[1]));
}
DI s16x4 vtr(const LAS unsigned char* p) { return __builtin_bit_cast(s16x4, __builtin_amdgcn_ds_read_tr16_b64_v4i16((LAS v4i16_t*)p)); }
template <int DV, bool OT = false> DI void pv_tile(f32x16* o, unsigned vb_addr, const u32x4* pw, int lane, int hi, int var = 0) {
    if (var & 1) { asm volatile("" :: "v"(pw[0]), "v"(pw[1]), "v"(pw[2]), "v"(pw[3])); return; }
    const unsigned vb = vb_addr + ((lane >> 4) & 1) * 32 + (lane & 3) * 8 + (4 * hi + ((lane & 15) >> 2)) * 64;
#pragma unroll
    for (int d0 = 0; d0 < DV / 32; ++d0) {
        s16x4 lo[4], hh[4];
#pragma unroll
        for (int ks = 0; ks < 4; ++ks) {
            asm volatile("ds_read_b64_tr_b16 %0, %1 offset:%c2" : "=&v"(lo[ks]) : "v"(vb), "i"(d0 * 4096 + ks * 1024) : "memory");
            asm volatile("ds_read_b64_tr_b16 %0, %1 offset:%c2" : "=&v"(hh[ks]) : "v"(vb), "i"(d0 * 4096 + ks * 1024 + 512) : "memory"); }
        asm volatile("s_waitcnt lgkmcnt(0)" ::: "memory"); __builtin_amdgcn_sched_barrier(0);
#pragma unroll
        for (int ks = 0; ks < 4; ++ks) { const bf16x8 vf = {lo[ks][0], lo[ks][1], lo[ks][2], lo[ks][3], hh[ks][0], hh[ks][1], hh[ks][2], hh[ks][3]};
            if (OT) o[d0] = MFMA32(vf, __builtin_bit_cast(bf16x8, pw[ks]), o[d0]); else o[d0] = MFMA32(__builtin_bit_cast(bf16x8, pw[ks]), vf, o[d0]); }
    }
}
DI void pack_p(u32x4* pw, const f32x16& p0, const f32x16& p1) {
#pragma unroll
    for (int i = 0; i < 4; ++i) { pw[0][i] = pk2(p0[2 * i], p0[2 * i + 1]); pw[1][i] = pk2(p0[8 + 2 * i], p0[8 + 2 * i + 1]); pw[2][i] = pk2(p1[2 * i], p1[2 * i + 1]); pw[3][i] = pk2(p1[8 + 2 * i], p1[8 + 2 * i + 1]); }
}
template <int ND> DI void scale_rows(f32x16* o, float fac, LAS float* wsf, int r32, int hi) {
    if (hi == 0) wsf[r32] = fac;
    LDS_WAIT();
#pragma unroll
    for (int g4 = 0; g4 < 4; ++g4) { const f32x4 f = *(const LAS f32x4*)(wsf + 8 * g4 + 4 * hi);
#pragma unroll
        for (int d0 = 0; d0 < ND; ++d0)
#pragma unroll
            for (int i = 0; i < 4; ++i) o[d0][4 * g4 + i] *= f[i]; }
    LDS_WAIT();
}
template <int ND> DI void axpy_rows(f32x16* acc, const f32x16* o, float fac, LAS float* wsf, int r32, int hi) {
    if (hi == 0) wsf[r32] = fac;
    LDS_WAIT();
#pragma unroll
    for (int g4 = 0; g4 < 4; ++g4) { const f32x4 f = *(const LAS f32x4*)(wsf + 8 * g4 + 4 * hi);
#pragma unroll
        for (int d0 = 0; d0 < ND; ++d0)
#pragma unroll
            for (int i = 0; i < 4; ++i) acc[d0][4 * g4 + i] += f[i] * o[d0][4 * g4 + i]; }
    LDS_WAIT();
}
template <int ND, bool FIRST> DI void axpy_rows_lds(LAS float* accw, const f32x16* o, float fac, LAS float* wsf, int r32, int hi) {
    if (hi == 0) wsf[r32] = fac;
    LDS_WAIT();
#pragma unroll
    for (int g4 = 0; g4 < 4; ++g4) { const f32x4 f = *(const LAS f32x4*)(wsf + 8 * g4 + 4 * hi);
#pragma unroll
        for (int d0 = 0; d0 < ND; ++d0)
#pragma unroll
            for (int i = 0; i < 4; ++i) { const int idx = (d0 * 16 + 4 * g4 + i) * 64; float v = f[i] * o[d0][4 * g4 + i]; if (!FIRST) v += accw[idx]; accw[idx] = v; } }
    LDS_WAIT();
}
template <int DV, bool OT = false> DI void softmax_pv(f32x16& p0, f32x16& p1, f32x16* o, float& m, float& l, unsigned Vb, LAS float* wsf, int lane, int r32, int hi, bool lane_on = true, int var = 0) {
    const float mt = lane_on ? rowmax32(p0, p1) : NEG_INF_F;
    const bool grow = mt > m + 8.0f;
    if (__any(grow)) { const float mn = grow ? mt : m; const float alpha = fast_exp2(m - mn); l *= alpha; m = mn;
        if (OT) {
#pragma unroll
            for (int d = 0; d < DV / 32; ++d)
#pragma unroll
                for (int r = 0; r < 16; ++r) o[d][r] *= alpha;
        } else scale_rows<DV / 32>(o, alpha, wsf, r32, hi); }
    const float msub = lane_on ? m : __builtin_inff();
    float s0 = 0.f, s1 = 0.f, s2 = 0.f, s3 = 0.f;
#pragma unroll
    for (int r = 0; r < 16; ++r) { if (var & 2) { p0[r] = p0[r] - msub; p1[r] = p1[r] - msub; } else { p0[r] = fast_exp2(p0[r] - msub); p1[r] = fast_exp2(p1[r] - msub); } }
#pragma unroll
    for (int r = 0; r < 16; r += 4) { s0 += p0[r] + p1[r]; s1 += p0[r + 1] + p1[r + 1]; s2 += p0[r + 2] + p1[r + 2]; s3 += p0[r + 3] + p1[r + 3]; }
    l += (s0 + s1) + (s2 + s3);
    u32x4 pw[4]; pack_p(pw, p0, p1);
    pv_tile<DV, OT>(o, Vb, pw, lane, hi, var);
}
DI float max3a(float a, float b, float c) { float d; asm volatile("v_max3_f32 %0, %1, %2, %3" : "=v"(d) : "v"(a), "v"(b), "v"(c)); return d; }
DI float max2a(float a, float b) { float d; asm volatile("v_max_f32 %0, %1, %2" : "=v"(d) : "v"(a), "v"(b)); return d; }
DI float rowmax32a(const f32x16& p0, const f32x16& p1) {
    __builtin_amdgcn_sched_barrier(0);
    asm volatile("s_nop 7\n\ts_nop 7\n\ts_nop 7" ::: "memory");
    float a[4];
#pragma unroll
    for (int c = 0; c < 4; ++c) { float x = max3a(p0[c], p1[c], p0[c + 4]); x = max3a(x, p1[c + 4], p0[c + 8]); x = max3a(x, p1[c + 8], p0[c + 12]); a[c] = max2a(x, p1[c + 12]); }
    const float t = max2a(max3a(a[0], a[1], a[2]), a[3]);
    auto rr = __builtin_amdgcn_permlane32_swap(__float_as_uint(t), __float_as_uint(t), false, false);
    return max2a(__uint_as_float(rr[0]), __uint_as_float(rr[1]));
}
DI f32x16 splat16(float v) { const f32x16 z = {v, v, v, v, v, v, v, v, v, v, v, v, v, v, v, v}; return z; }
template <int DV> DI void softmax_pv_c(f32x16& p0, f32x16& p1, f32x16* o, float& m, float& l, f32x16& nm, bool& st, unsigned Vb, int lane, int hi, int var = 0) {
    const float mt = rowmax32a(p0, p1);
    const bool fin = mt > -1e30f;
    const bool grow = (mt > 8.0f) || (!st && fin);
    st = st || fin;
    if (__any(grow)) { const float d = grow ? mt : 0.f; const float alpha = fast_exp2(-d); l *= alpha; m += d; nm = splat16(-m);
#pragma unroll
        for (int dd = 0; dd < DV / 32; ++dd)
#pragma unroll
            for (int r = 0; r < 16; ++r) o[dd][r] *= alpha;
#pragma unroll
        for (int r = 0; r < 16; ++r) { p0[r] -= d; p1[r] -= d; } }
    float s0 = 0.f, s1 = 0.f, s2 = 0.f, s3 = 0.f;
#pragma unroll
    for (int r = 0; r < 16; ++r) { p0[r] = fast_exp2(p0[r]); p1[r] = fast_exp2(p1[r]); }
#pragma unroll
    for (int r = 0; r < 16; r += 4) { s0 += p0[r] + p1[r]; s1 += p0[r + 1] + p1[r + 1]; s2 += p0[r + 2] + p1[r + 2]; s3 += p0[r + 3] + p1[r + 3]; }
    l += (s0 + s1) + (s2 + s3);
    u32x4 pw[4]; pack_p(pw, p0, p1);
    pv_tile<DV, true>(o, Vb, pw, lane, hi, var);
}
template <int N> DI void wait_bar() { asm volatile("s_waitcnt vmcnt(%0) lgkmcnt(0)\n\ts_barrier" :: "n"(N) : "memory"); }
template <int DQK, int DV, class KS, class VS, class Body>
DI void tile_pipeline(int n, LAS unsigned char* lds, int kb0, int vb0, int kpitch, int vpitch, int wave, int lane, KS ksrc, VS vsrc, Body body) {
    constexpr int KSZ = DQK * 128, VSZ = DV * 128, IPT = DQK / 64 + DV / 64;
    int c = 0, n1 = 1, n2 = 2;
    if (n > 0) { dma_k<DQK>(ksrc(0), kpitch, lds + kb0, wave, lane); if (DV) dma_v<DV ? DV : 64>(vsrc(0), vpitch, lds + vb0, wave, lane); }
    if (n > 1) { dma_k<DQK>(ksrc(1), kpitch, lds + kb0 + KSZ, wave, lane); if (DV) dma_v<DV ? DV : 64>(vsrc(1), vpitch, lds + vb0 + VSZ, wave, lane); }
#pragma unroll 1
    for (int j = 0; j < n; ++j) {
        if (j + 1 < n) wait_bar<IPT>(); else wait_bar<0>();
        if (j + 2 < n) { dma_k<DQK>(ksrc(j + 2), kpitch, lds + kb0 + n2 * KSZ, wave, lane); if (DV) dma_v<DV ? DV : 64>(vsrc(j + 2), vpitch, lds + vb0 + n2 * VSZ, wave, lane); }
        body(j, (const LAS unsigned char*)(lds + kb0 + c * KSZ), (unsigned)(vb0 + c * VSZ));
        const int t = c; c = n1; n1 = n2; n2 = t;
    }
    wait_bar<0>();
}
template <int N> DI void wait_bar_sel(int naux) { if (naux == 8) wait_bar<N + 8>(); else if (naux == 4) wait_bar<N + 4>(); else wait_bar<N>(); }
template <int DQK, int DV, class KS, class VS, class Body, class Aux>
DI void tile_pipeline_aux(int n, LAS unsigned char* lds, int kb0, int vb0, int kpitch, int vpitch, int wave, int lane, KS ksrc, VS vsrc, Body body, Aux aux) {
    constexpr int KSZ = DQK * 128, VSZ = DV * 128, IPT = DQK / 64 + DV / 64;
    int c = 0, n1 = 1, n2 = 2, naux = 0;
    if (n > 0) { dma_k<DQK>(ksrc(0), kpitch, lds + kb0, wave, lane); dma_v<DV>(vsrc(0), vpitch, lds + vb0, wave, lane); }
    if (n > 1) { dma_k<DQK>(ksrc(1), kpitch, lds + kb0 + KSZ, wave, lane); dma_v<DV>(vsrc(1), vpitch, lds + vb0 + VSZ, wave, lane); }
#pragma unroll 1
    for (int j = 0; j < n; ++j) {
        if (j + 1 < n) wait_bar_sel<IPT>(naux); else wait_bar_sel<0>(naux);
        naux = aux(j, n);
        if (j + 2 < n) { dma_k<DQK>(ksrc(j + 2), kpitch, lds + kb0 + n2 * KSZ, wave, lane); dma_v<DV>(vsrc(j + 2), vpitch, lds + vb0 + n2 * VSZ, wave, lane); }
        body(j, (const LAS unsigned char*)(lds + kb0 + c * KSZ), (unsigned)(vb0 + c * VSZ));
        const int t = c; c = n1; n1 = n2; n2 = t;
    }
    wait_bar<0>();
}
constexpr int A_KB = 0, A_VB = 24576, A_WS = 49152, A_IMP = 57344, A_OST = 57344, A_ACC = 90112;
static_assert(A_ACC + 65536 <= LDS_MISC, "NSA attention LDS map");
DI unsigned okey(float f) { const unsigned u = __float_as_uint(f); return (u >> 31) ? ~u : (u | 0x80000000u); }

DI float quad_sum(float v) {
    v += __builtin_bit_cast(float, __builtin_amdgcn_mov_dpp(__builtin_bit_cast(int, v), 0xB1, 0xF, 0xF, true));
    v += __builtin_bit_cast(float, __builtin_amdgcn_mov_dpp(__builtin_bit_cast(int, v), 0x4E, 0xF, 0xF, true));
    return v;
}
template <int VAR> DI void nsa_attn_unit(Frame& F, int b, int g, int bi) {
    const int lane = F.lane, wave = F.wave, r32 = lane & 31, hi = lane >> 5;
    LAS unsigned char* lds = F.lds;
    LAS float* wsf = (LAS float*)(lds + A_WS + wave * 1024);
    LAS unsigned long long* wmask = (LAS unsigned long long*)(lds + A_WS + wave * 1024 + 256);
    LAS float* imp = (LAS float*)(lds + A_IMP) + wave * 8 * 128;
    f32x16 oacc[2]; oacc[0] = zero16(); oacc[1] = zero16();
    const int qq = r32 >> 2, hd = r32 & 3, qloc = 8 * wave + qq;
    const int tpos = 64 * bi + qloc;
    const bf16_t* P = (const bf16_t*)(F.ws + WS_PBUF);
    const bf16_t* Q = (const bf16_t*)(F.ws + WS_QA); const bf16_t* QR = Q + (size_t)T * DM; const bf16_t* KS = QR + (size_t)T * DM; const bf16_t* KW = KS + (size_t)T * 256;
    const bf16_t* KC = (const bf16_t*)(F.ws + WS_KCMP); const bf16_t* VC = (const bf16_t*)(F.ws + WS_VCMP);
#define NSA_GATE(br) ({ const int lo_ = opq(F.lane); const int r32o = lo_ & 31; ((const float*)(F.ws + WS_GATES))[((size_t)b * SEQ + 64 * bi + 8 * wave + (r32o >> 2)) * 48 + 16 * (br) + 4 * g + (r32o & 3)]; })
    unsigned long long wor_lo = 0ull, wor_hi = 0ull;
    {
        const int lane = opq(F.lane);
        bf16x8 qf[4];
        { const int r32o = lane & 31, hio = lane >> 5; const size_t toko = (size_t)b * SEQ + 64 * bi + 8 * wave + (r32o >> 2);
#pragma unroll
        for (int d0 = 0; d0 < 4; ++d0) qf[d0] = *(const bf16x8*)(Q + toko * DM + (4 * g + (r32o & 3)) * 64 + 16 * d0 + 8 * hio); }
        const int nmax = (4 * bi + 3 < NCMP) ? 4 * bi + 3 : NCMP; const int nct = (nmax + 63) >> 6;
        const int nv = tpos >= 31 ? ((tpos - 31) >> 4) + 1 : 0;
        const bf16_t* kc0 = KC + ((size_t)b * NCMPP * 4 + g) * 64; const bf16_t* vc0 = VC + ((size_t)b * NCMPP * 4 + g) * 64;
        float m = -1e30f, l = 0.f;
        tile_pipeline<64, 0>(nct, lds, A_KB, A_VB, 256, 256, wave, lane,
            [&](int t) { return KSrc{kc0 + (size_t)t * 64 * 256, nullptr}; }, [&](int t) { return vc0; },
            [&](int ct, const LAS unsigned char* Kb, unsigned Vb) {
                f32x16 p0, p1; qk_tile<64>(p0, p1, Kb, qf, r32, hi);
                if (__any(64 * ct + 63 >= nv)) {
#pragma unroll
                    for (int r = 0; r < 16; ++r) { const int n = 64 * ct + crow(r, hi); if (n >= nv) p0[r] = NEG_INF_F; if (n + 32 >= nv) p1[r] = NEG_INF_F; }
                }
                const float mt = rowmax32(p0, p1), mn = fmaxf(m, mt);
                float s0 = 0.f, s1 = 0.f, s2 = 0.f, s3 = 0.f;
#pragma unroll
                for (int r = 0; r < 16; r += 4) { s0 += fast_exp2(p0[r] - mn) + fast_exp2(p1[r] - mn); s1 += fast_exp2(p0[r + 1] - mn) + fast_exp2(p1[r + 1] - mn);
                    s2 += fast_exp2(p0[r + 2] - mn) + fast_exp2(p1[r + 2] - mn); s3 += fast_exp2(p0[r + 3] - mn) + fast_exp2(p1[r + 3] - mn); }
                l = l * fast_exp2(m - mn) + ((s0 + s1) + (s2 + s3)); m = mn;
            });
        const float ltot = l + partner32(l, hi);
        const float inv = ltot > 0.f ? 1.0f / ltot : 0.f;
        f32x16 oc[2]; oc[0] = zero16(); oc[1] = zero16();
        float cprev = 0.f;
        tile_pipeline<64, 64>(nct, lds, A_KB, A_VB, 256, 256, wave, lane,
            [&](int t) { return KSrc{kc0 + (size_t)t * 64 * 256, nullptr}; }, [&](int t) { return vc0 + (size_t)t * 64 * 256; },
            [&](int ct, const LAS unsigned char* Kb, unsigned Vb) {
                f32x16 p0, p1; qk_tile<64>(p0, p1, Kb, qf, r32, hi);
                if (__any(64 * ct + 63 >= nv)) {
#pragma unroll
                    for (int r = 0; r < 16; ++r) { const int n = 64 * ct + crow(r, hi);
                        p0[r] = (n < nv) ? fast_exp2(p0[r] - m) * inv : 0.f; p1[r] = (n + 32 < nv) ? fast_exp2(p1[r] - m) * inv : 0.f; }
                } else {
#pragma unroll
                    for (int r = 0; r < 16; ++r) { p0[r] = fast_exp2(p0[r] - m) * inv; p1[r] = fast_exp2(p1[r] - m) * inv; }
                }
                float mainv[8], e3v[8];
#pragma unroll
                for (int k = 0; k < 8; ++k) { const f32x16& src = (k < 4) ? p0 : p1; const int bs = 4 * (k & 3);
                    float mv = 2.0f * (src[bs] + src[bs + 1] + src[bs + 2]) + src[bs + 3], ev = src[bs + 3];
                    mv = quad_sum(mv); ev = quad_sum(ev);
                    mainv[k] = mv; e3v[k] = ev; }
                float pe[8];
#pragma unroll
                for (int k = 0; k < 8; ++k) pe[k] = partner32(e3v[k], hi);
#pragma unroll
                for (int k = 0; k < 8; ++k) { const float carry = hi ? pe[k] : (k > 0 ? pe[k > 0 ? k - 1 : 0] : cprev);
                    if (hd == 0) imp[qq * 128 + 16 * ct + 2 * k + hi] = mainv[k] + carry; }
                cprev = pe[7];
                u32x4 pw[4]; pack_p(pw, p0, p1);
                pv_tile<64, true>(oc, Vb, pw, lane, hi);
            });
        { float gate_c = NSA_GATE(0);
#ifdef DBG_NO_C
          gate_c = 0.f;
#endif
#pragma unroll
          for (int d = 0; d < 2; ++d)
#pragma unroll
              for (int r = 0; r < 16; ++r) oacc[d][r] = gate_c * oc[d][r]; }
        {
            unsigned k0[8], k1[8], prefix[8]; int cnt16[8] = {0, 0, 0, 0, 0, 0, 0, 0};
            const int j0 = lane, j1 = lane + 64;
            const bool f0 = (j0 == 0) || (j0 == bi) || (j0 == bi - 1), f1 = (j1 == bi) || (j1 == bi - 1);
#pragma unroll
            for (int q8 = 0; q8 < 8; ++q8) { const LAS float* ir = imp + q8 * 128;
                const float s0 = f0 ? 1.0e4f : (j0 <= bi ? ir[j0] : -1.0f), s1 = f1 ? 1.0e4f : (j1 <= bi ? ir[j1 <= bi ? j1 : 0] : -1.0f);
                k0[q8] = okey(s0); k1[q8] = okey(s1); prefix[q8] = 0u; }
            if (bi >= 16) {
#pragma unroll
                for (int q8 = 0; q8 < 8; ++q8) prefix[q8] = 0x80000000u;
                if (bi >= 64) {
#pragma unroll 1
                    for (int bit = 30; bit >= 0; --bit) {
                        int open = 0;
#pragma unroll
                        for (int q8 = 0; q8 < 8; ++q8) { const unsigned trial = prefix[q8] | (1u << bit);
                            const int c = __popcll(__ballot(k0[q8] >= trial)) + __popcll(__ballot(k1[q8] >= trial));
                            if (c >= 16) { prefix[q8] = trial; cnt16[q8] = c; }
                            open |= cnt16[q8] ^ 16; }
                        if (open == 0) break;
                    }
                } else {
#pragma unroll 1
                    for (int bit = 30; bit >= 0; --bit) {
                        int open = 0;
#pragma unroll
                        for (int q8 = 0; q8 < 8; ++q8) { const unsigned trial = prefix[q8] | (1u << bit);
                            const int c = __popcll(__ballot(k0[q8] >= trial));
                            if (c >= 16) { prefix[q8] = trial; cnt16[q8] = c; }
                            open |= cnt16[q8] ^ 16; }
                        if (open == 0) break;
                    }
                }
            } else {
#pragma unroll 1
                for (int bit = 31; bit >= 0; --bit) {
#pragma unroll
                    for (int q8 = 0; q8 < 8; ++q8) { const unsigned trial = prefix[q8] | (1u << bit);
                        const int c = __popcll(__ballot(k0[q8] >= trial)) + __popcll(__ballot(k1[q8] >= trial));
                        if (c >= 16) prefix[q8] = trial; }
                }
            }
            const unsigned long long lt = (1ull << lane) - 1ull;
#pragma unroll
            for (int q8 = 0; q8 < 8; ++q8) {
                const unsigned pf = prefix[q8];
                const unsigned long long gt0 = __ballot(k0[q8] > pf), gt1 = __ballot(k1[q8] > pf), eq0 = __ballot(k0[q8] == pf), eq1 = __ballot(k1[q8] == pf);
                const int need = 16 - (__popcll(gt0) + __popcll(gt1));
                const int rk0 = __popcll(eq0 & lt), rk1 = __popcll(eq0) + __popcll(eq1 & lt);
                const bool sel0 = (k0[q8] > pf) || (k0[q8] == pf && rk0 < need), sel1 = (k1[q8] > pf) || (k1[q8] == pf && rk1 < need);
                const unsigned long long m0 = __ballot(sel0), m1 = __ballot(sel1);
                if (lane == 0) { wmask[2 * q8] = m0; wmask[2 * q8 + 1] = m1; }
                wor_lo |= m0; wor_hi |= m1;
            }
        }
        LDS_WAIT();
    }
    bf16x8 qr[4];
    { const int lo_ = opq(F.lane); const int r32o = lo_ & 31, hio = lo_ >> 5; const int tq = 64 * bi + 8 * wave + (r32o >> 2); const size_t toko = (size_t)b * SEQ + tq;
      const float* ctq = (const float*)(F.ws + WS_ROPE) + tq * 32 + 8 * hio; const float* stq = ctq + SEQ * 32;
#pragma unroll
      for (int p2 = 0; p2 < 2; ++p2) {
          const u32x4 w1 = *(const u32x4*)(Q + toko * DM + (4 * g + (r32o & 3)) * 64 + 16 * p2 + 8 * hio), w2 = *(const u32x4*)(Q + toko * DM + (4 * g + (r32o & 3)) * 64 + 32 + 16 * p2 + 8 * hio);
          const f32x4 ca = *(const f32x4*)(ctq + 16 * p2), cb = *(const f32x4*)(ctq + 16 * p2 + 4), sa = *(const f32x4*)(stq + 16 * p2), sb = *(const f32x4*)(stq + 16 * p2 + 4);
          float x1[8], x2[8], r1[8], r2[8];
          unpack8(w1, x1); unpack8(w2, x2);
#pragma unroll
          for (int i = 0; i < 8; ++i) { const float cc = i < 4 ? ca[i & 3] : cb[i & 3], ss = i < 4 ? sa[i & 3] : sb[i & 3]; r1[i] = x1[i] * cc - x2[i] * ss; r2[i] = x2[i] * cc + x1[i] * ss; }
          qr[p2] = __builtin_bit_cast(bf16x8, pack8f(r1)); qr[p2 + 2] = __builtin_bit_cast(bf16x8, pack8f(r2)); } }
    {
        const int lane = opq(F.lane);
        f32x16 os[2]; os[0] = zero16(); os[1] = zero16();
        float m = 0.f, l = 0.f; f32x16 nm = zero16(); bool st = false;
        const bf16_t* k0p = KS + (size_t)b * SEQ * 256 + g * 64; const bf16_t* v0p = P + (size_t)b * SEQ * NSA_INP + PC_VS + g * 64;
        int cst = 0;
        tile_pipeline_aux<64, 64>((VAR & 16) ? 0 : bi + 1, lds, A_KB, A_VB, 256, NSA_INP, wave, lane,
            [&](int t) { return KSrc{k0p + (size_t)t * 64 * 256, nullptr}; }, [&](int t) { return v0p + (size_t)t * 64 * NSA_INP; },
            [&](int j, const LAS unsigned char* Kb, unsigned Vb) {
                const bool wact = (((j < 64) ? (wor_lo >> j) : (wor_hi >> (j - 64))) & 1ull) != 0ull;
                if (wact) {
                    const bool sel = ((wmask[2 * qq + (j >> 6)] >> (j & 63)) & 1ull) != 0ull;
                    f32x16 ci;
#pragma unroll
                    for (int r = 0; r < 16; ++r) ci[r] = sel ? nm[r] : NEG_INF_F;
                    f32x16 p0, p1; qk_tile<64>(p0, p1, Kb, qr, r32, hi, VAR, &ci);
                    if (j == bi) {
#pragma unroll
                        for (int r = 0; r < 16; ++r) { const int kl = crow(r, hi); if (kl > qloc) p0[r] = NEG_INF_F; if (kl + 32 > qloc) p1[r] = NEG_INF_F; }
                    }
                    softmax_pv_c<64>(p0, p1, os, m, l, nm, st, Vb, lane, hi, VAR);
                }
            },
            [&](int j, int n) -> int {
                LAS unsigned char* cscr = lds + A_ACC + wave * 8192;
                if (cst == 2) { const ConvItem ci_ = conv_item2(F.in, F.ws, F.cv_L, F.cv_it); conv_finish(ci_, cscr, opq(F.lane)); LDS_WAIT(); F.cv_it += F.G * NWAVES; cst = 0; return 4; }
                if (cst == 1) { cst = 2; return 0; }
                if ((j & 7) == 0 && j + 2 < n && F.cv_it < F.cv_end) { const ConvItem ci_ = conv_item2(F.in, F.ws, F.cv_L, F.cv_it); conv_issue(ci_, cscr, opq(F.lane)); cst = 1; return 8; }
                return 0;
            });
        const float ltot = l + partner32(l, hi);
        { float gate_s = NSA_GATE(1);
#ifdef DBG_NO_S
          gate_s = 0.f;
#endif
          const float fac = ltot > 0.f ? gate_s / ltot : 0.f;
#pragma unroll
          for (int d = 0; d < 2; ++d)
#pragma unroll
              for (int r = 0; r < 16; ++r) oacc[d][r] += fac * os[d][r]; }
    }
    {
        const int lane = opq(F.lane);
        f32x16 ow[2]; ow[0] = zero16(); ow[1] = zero16();
        float m = 0.f, l = 0.f; f32x16 nm = zero16(); bool st = false;
        const int jt0 = bi >= 8 ? bi - 8 : 0;
        const bf16_t* k0p = KW + (size_t)b * SEQ * 256 + g * 64; const bf16_t* v0p = P + (size_t)b * SEQ * NSA_INP + PC_VW + g * 64;
        tile_pipeline<64, 64>((VAR & 16) ? 0 : bi - jt0 + 1, lds, A_KB, A_VB, 256, NSA_INP, wave, lane,
            [&](int t) { return KSrc{k0p + (size_t)(jt0 + t) * 64 * 256, nullptr}; }, [&](int t) { return v0p + (size_t)(jt0 + t) * 64 * NSA_INP; },
            [&](int t, const LAS unsigned char* Kb, unsigned Vb) {
                const int jt = jt0 + t;
                f32x16 p0, p1; qk_tile<64>(p0, p1, Kb, qr, r32, hi, VAR, &nm);
                if (jt == bi - 8) {
#pragma unroll
                    for (int r = 0; r < 16; ++r) { const int kl = crow(r, hi); if (kl <= qloc) p0[r] = NEG_INF_F; if (kl + 32 <= qloc) p1[r] = NEG_INF_F; }
                } else if (jt == bi) {
#pragma unroll
                    for (int r = 0; r < 16; ++r) { const int kl = crow(r, hi); if (kl > qloc) p0[r] = NEG_INF_F; if (kl + 32 > qloc) p1[r] = NEG_INF_F; }
                }
                softmax_pv_c<64>(p0, p1, ow, m, l, nm, st, Vb, lane, hi, VAR);
            });
        const float ltot = l + partner32(l, hi);
        { float gate_w = NSA_GATE(2);
#ifdef DBG_NO_W
          gate_w = 0.f;
#endif
          const float fac = ltot > 0.f ? gate_w / ltot : 0.f;
#pragma unroll
          for (int d = 0; d < 2; ++d)
#pragma unroll
              for (int r = 0; r < 16; ++r) oacc[d][r] += fac * ow[d][r]; }
    }
    {
        const int lane = opq(F.lane);
        LAS bf16_t* stg = (LAS bf16_t*)(lds + A_OST) + wave * 2048;
#pragma unroll
        for (int d0 = 0; d0 < 2; ++d0)
#pragma unroll
            for (int g4 = 0; g4 < 4; ++g4) { u32x2 w; w.x = pk2(oacc[d0][4 * g4], oacc[d0][4 * g4 + 1]); w.y = pk2(oacc[d0][4 * g4 + 2], oacc[d0][4 * g4 + 3]);
                *(LAS u32x2*)(stg + r32 * 64 + 32 * d0 + 8 * g4 + 4 * hi) = w; }
        LDS_WAIT();
        bf16_t* O = (bf16_t*)(F.ws + (VAR >= 8 ? WS_H : WS_O));
#pragma unroll
        for (int i = 0; i < 4; ++i) { const int row = i * 8 + (lane >> 3), ch = lane & 7;
            const u32x4 v = *(const LAS u32x4*)(stg + row * 64 + ch * 8);
            *(u32x4*)(O + ((size_t)b * SEQ + 64 * bi + 8 * wave + (row >> 2)) * DM + (4 * g + (row & 3)) * 64 + ch * 8) = v; }
        LDS_WAIT();
    }
#undef NSA_GATE
}


template <bool MLA>
DI void narrow_unit(Frame& F, const bf16_t* Hn, const bf16_t* Wn, int pm, int j) {
    const int tid = opq(F.tid), lane = tid & 63, wid = tid >> 6, hi = lane >> 5, tk = lane & 31;
    __syncthreads();
    {
        const int a = lane >> 3, rho = 8 * wid + (lane & 7);
        int wrow = rho;
        if (MLA) { const int n = rho >> 5, rem = rho & 31; wrow = 8 * (rem >> 2) + 4 * n + (rem & 3); }
        const char* src = (const char*)Wn + (size_t)wrow * (DM * 2) + a * 16;
        LAS unsigned char* dst = F.lds + (a * 64 + rho) * 16;
        u32x4 v[16];
#pragma unroll
        for (int i = 0; i < 16; ++i) v[i] = *(const GAS u32x4*)(src + i * 128);
#pragma unroll
        for (int i = 0; i < 16; ++i) *(LAS u32x4*)(dst + i * 8192) = v[i];
    }
    const int row = pm * 256 + 32 * wid + tk;
    const char* hp = (const char*)Hn + (size_t)(pm * 256 + 32 * wid + (lane >> 2)) * (DM * 2) + (lane & 3) * 16;
    LAS unsigned char* stg = F.lds + 131072 + wid * 2048;
    const int wofs = (lane >> 2) * 64 + (((lane & 3) + (lane >> 4)) & 3) * 16;
    const int rofs0 = tk * 64 + ((hi + (tk >> 2)) & 3) * 16, rofs1 = tk * 64 + ((2 + hi + (tk >> 2)) & 3) * 16;
    const LAS unsigned char* wp = F.lds + hi * 1024 + tk * 16;
    f32x16 acc0 = splat16(0.f), acc1 = splat16(0.f);
    u32x4 hbuf[8][2];
#pragma unroll
    for (int d = 0; d < 8; ++d) { hbuf[d][0] = *(const GAS u32x4*)(hp + d * 64); hbuf[d][1] = *(const GAS u32x4*)(hp + 16 * DM * 2 + d * 64); }
    LDS_WAIT(); __syncthreads();
    bf16x8 fb[2][2], fa[2][4];
#define NU_STAGE(Kt_) do { *(LAS u32x4*)(stg + wofs) = hbuf[(Kt_) & 7][0]; *(LAS u32x4*)(stg + wofs + 1024) = hbuf[(Kt_) & 7][1]; \
        __builtin_amdgcn_sched_barrier(0);                    \
        if ((Kt_) + 8 < 32) { hbuf[(Kt_) & 7][0] = *(const GAS u32x4*)(hp + ((Kt_) + 8) * 64); hbuf[(Kt_) & 7][1] = *(const GAS u32x4*)(hp + 16 * DM * 2 + ((Kt_) + 8) * 64); } \
        __builtin_amdgcn_sched_barrier(0); \
        fb[(Kt_) & 1][0] = *(const LAS bf16x8*)(stg + rofs0); fb[(Kt_) & 1][1] = *(const LAS bf16x8*)(stg + rofs1); \
        _Pragma("unroll") for (int q = 0; q < 4; ++q) fa[(Kt_) & 1][q] = *(const LAS bf16x8*)(wp + (4 * (Kt_) + 2 * (q >> 1)) * 1024 + (q & 1) * 512); \
        __builtin_amdgcn_sched_barrier(0); } while (0)
    NU_STAGE(0);
#pragma unroll
    for (int Kt = 0; Kt < 32; ++Kt) {
        if (Kt + 1 < 32) NU_STAGE(Kt + 1);
#pragma unroll
        for (int ks = 0; ks < 2; ++ks) { acc0 = MFMA32(fa[Kt & 1][2 * ks], fb[Kt & 1][ks], acc0); acc1 = MFMA32(fa[Kt & 1][2 * ks + 1], fb[Kt & 1][ks], acc1); }
        __builtin_amdgcn_sched_barrier(0);
    }
#undef NU_STAGE
    if (!MLA) {
        float* gt = (float*)(F.ws + WS_GATES) + (size_t)row * 48 + 4 * hi;
#pragma unroll
        for (int qd = 0; qd < 6; ++qd) { f32x4 gv;
#pragma unroll
            for (int i = 0; i < 4; ++i) { const float a = qd < 4 ? acc0[4 * (qd & 3) + i] : acc1[4 * (qd & 3) + i]; const float x = __uint_as_float(pk2(a, 0.f) << 16); gv[i] = 1.0f / (1.0f + __expf(-x)); }
            *(f32x4*)(gt + 8 * qd) = gv; }
    } else {
        float ss = 0.f;
#pragma unroll
        for (int r = 0; r < 16; ++r) ss += acc0[r] * acc0[r] + acc1[r] * acc1[r];
        { auto rr = __builtin_amdgcn_permlane32_swap(__float_as_uint(ss), __float_as_uint(ss), false, false); ss = __uint_as_float(rr[0]) + __uint_as_float(rr[1]); }
        const float rs = __builtin_amdgcn_rsqf(ss * (1.0f / 64.0f) + RMS_EPS);
        const float* gkr = F.in[18] + j * 64; const float* ct = (const float*)(F.ws + WS_ROPE); const float* st = ct + SEQ * 32;
        bf16_t* kr = (bf16_t*)(F.ws + WS_HID) + (size_t)row * 64; const int t = row & (SEQ - 1);
#pragma unroll
        for (int qd = 0; qd < 4; ++qd) { const int q0 = 8 * qd + 4 * hi;
            const f32x4 g1 = *(const f32x4*)(gkr + q0), g2 = *(const f32x4*)(gkr + 32 + q0), c4 = *(const f32x4*)(ct + t * 32 + q0), s4 = *(const f32x4*)(st + t * 32 + q0);
            f32x4 a1, a2;
#pragma unroll
            for (int i = 0; i < 4; ++i) { a1[i] = acc0[4 * qd + i]; a2[i] = acc1[4 * qd + i]; }
            const f32x4 x1 = a1 * rs * g1, x2 = a2 * rs * g2;
            const f32x4 o1 = x1 * c4 - x2 * s4, o2 = x2 * c4 + x1 * s4;
            *(u32x2*)(kr + q0) = pg8::pack4(o1); *(u32x2*)(kr + 32 + q0) = pg8::pack4(o2); }
    }
}

template <int VAR> DI void nsa_attn_phase(Frame& F) {
    for (int v = F.vcu; v < 256; v += F.G) {
        const int pair = v >> 4, s = v & 15;
#pragma unroll 1
        for (int i = 0; i < 8; ++i) { const int bi = 32 * (i >> 1) + ((i & 1) ? 31 - s : s);
            nsa_attn_unit<VAR>(F, pair >> 2, pair & 3, bi); }
    }
#pragma unroll 1
    while (F.cv_it < F.cv_end) { LAS unsigned char* cscr = F.lds + A_ACC + F.wave * 8192; const ConvItem ci_ = conv_item2(F.in, F.ws, F.cv_L, F.cv_it);
        conv_issue(ci_, cscr, opq(F.lane)); asm volatile("s_waitcnt vmcnt(0)" ::: "memory"); conv_finish(ci_, cscr, opq(F.lane)); LDS_WAIT(); F.cv_it += F.G * NWAVES; }
}
constexpr int M_KB = 0, M_VB = 73728, M_WS = 122880, M_OST = 0;
static_assert(M_WS + 2048 <= LDS_MISC, "MLA attention LDS map");
DI void mla_attn_unit(Frame& F, int b, int h, int qb) {
    const int lane = F.lane, wave = F.wave, r32 = lane & 31, hi = lane >> 5;
    LAS unsigned char* lds = F.lds;
    LAS float* wsf = (LAS float*)(lds + M_WS + wave * 256);
    const bf16_t* Qf = (const bf16_t*)(F.ws + WS_QA); const bf16_t* Kn = Qf + (size_t)T * 1536; const bf16_t* Vf = Kn + (size_t)T * DM; const bf16_t* KR = (const bf16_t*)(F.ws + WS_HID);
    const int tq = 256 * qb + 32 * wave + r32;
    bf16x8 qf[12];
    { const int lo_ = opq(F.lane); const size_t toko = (size_t)b * SEQ + 256 * qb + 32 * wave + (lo_ & 31);
#pragma unroll
    for (int d0 = 0; d0 < 12; ++d0) qf[d0] = *(const bf16x8*)(Qf + toko * 1536 + h * 192 + 16 * d0 + 8 * (lo_ >> 5)); }
    f32x16 o[4]; o[0] = zero16(); o[1] = zero16(); o[2] = zero16(); o[3] = zero16();
    float m = 0.f, l = 0.f; f32x16 nm = zero16(); bool st = false;
    const int NT = 4 * qb + 4;
    const bf16_t* k0p = Kn + (size_t)b * SEQ * DM + h * 128; const bf16_t* krp = KR + (size_t)b * SEQ * 64; const bf16_t* v0p = Vf + (size_t)b * SEQ * DM + h * 128;
    const int wmin = 256 * qb + 32 * wave;
    tile_pipeline<192, 128>(NT, lds, M_KB, M_VB, DM, DM, wave, opq(F.lane),
        [&](int t) { return KSrc{k0p + (size_t)t * 64 * DM, krp + (size_t)t * 64 * 64}; }, [&](int t) { return v0p + (size_t)t * 64 * DM; },
        [&](int kt, const LAS unsigned char* Kb, unsigned Vb) {
            if (64 * kt <= wmin + 31) {
                f32x16 p0, p1; qk_tile<192>(p0, p1, Kb, qf, r32, hi, 0, &nm);
                if (64 * kt + 63 > wmin) {
                    const int lim = tq - 64 * kt;
#pragma unroll
                    for (int r = 0; r < 16; ++r) { const int kl = crow(r, hi); if (kl > lim) p0[r] = NEG_INF_F; if (kl + 32 > lim) p1[r] = NEG_INF_F; }
                }
                softmax_pv_c<128>(p0, p1, o, m, l, nm, st, Vb, lane, hi);
            }
        });
    const float ltot = l + partner32(l, hi);
    const float invl = ltot > 0.f ? 1.0f / ltot : 0.f;
    {
        const int lane = opq(F.lane);
        LAS bf16_t* stg = (LAS bf16_t*)(lds + M_OST) + wave * 4096;
#pragma unroll
        for (int d0 = 0; d0 < 4; ++d0)
#pragma unroll
            for (int g4 = 0; g4 < 4; ++g4) { u32x2 w; w.x = pk2(o[d0][4 * g4] * invl, o[d0][4 * g4 + 1] * invl); w.y = pk2(o[d0][4 * g4 + 2] * invl, o[d0][4 * g4 + 3] * invl);
                *(LAS u32x2*)(stg + r32 * 128 + 32 * d0 + 8 * g4 + 4 * hi) = w; }
        LDS_WAIT();
        bf16_t* O = (bf16_t*)(F.ws + WS_O);
#pragma unroll
        for (int i = 0; i < 8; ++i) { const int row = i * 4 + (lane >> 4), ch = lane & 15;
            const u32x4 v = *(const LAS u32x4*)(stg + row * 128 + ch * 8);
            *(u32x4*)(O + ((size_t)b * SEQ + 256 * qb + 32 * wave + row) * DM + h * 128 + ch * 8) = v; }
    }
    asm volatile("s_waitcnt lgkmcnt(0)\n\ts_barrier" ::: "memory");
}
DI void mla_attn_phase(Frame& F) {
    for (int v = F.vcu; v < 256; v += F.G) {
        const int bh = v >> 3, s = v & 7;
#pragma unroll 1
        for (int i = 0; i < 4; ++i) { const int qb = (i == 0) ? s : (i == 1) ? 15 - s : (i == 2) ? 16 + s : 31 - s;
            mla_attn_unit(F, bh >> 3, bh & 7, qb); }
    }
}
#ifndef MK_ONE_LAUNCH
#define MK_ONE_LAUNCH 1
#endif
constexpr int N_PHASES = 42;
struct Args { const float* in[27]; float* out; unsigned char* ws; int ph_lo, ph_hi; };

DI void moe_tables(Frame& F, int L, LAS int* tst, LAS int* cntl) {
    const int* cnt = (const int*)(F.ws + WS_TOT);
    __syncthreads();
    if (F.tid < NEXP) cntl[F.tid] = cnt[F.tid];
    __syncthreads();
    if (F.tid == 0) { int s = 0; for (int e = 0; e < NEXP; ++e) { tst[e] = s; s += (cntl[e] + 255) >> 8; } tst[NEXP] = s; }
    __syncthreads();
}

__global__ void __launch_bounds__(NTHREADS, 2) fwd_kernel(Args args) {
    extern __shared__ __attribute__((aligned(16))) unsigned char lds_raw[];
    Frame F;
    F.lds = (LAS unsigned char*)lds_raw; F.ws = args.ws; F.in = args.in;
    F.wave = __builtin_amdgcn_readfirstlane((int)threadIdx.x >> 6); F.lane = lane_id(); F.tid = F.wave * 64 + F.lane;
    F.G = gridDim.x; F.bid = blockIdx.x; F.vcu = (F.G % 8 == 0) ? (F.bid % 8) * (F.G / 8) + F.bid / 8 : F.bid;
    volatile LAS unsigned* MISC = (volatile LAS unsigned*)(F.lds + LDS_MISC);
    for (int u = F.tid; u < (LDS_BYTES - LDS_MISC) / 4; u += NTHREADS) MISC[u] = 0u;
    __syncthreads();
    const int lo = args.ph_lo, hi = args.ph_hi;
    unsigned* ctl = (unsigned*)(F.ws + WS_CTL);
    XcdBarrier bar; bar.bar = ctl + CW_BAR; bar.x = 0; bar.st = MISC + 8;
    if (hi - lo > 1) bar = xcd_barrier_post(ctl + CW_BAR, MISC + 8, F.tid == 0);
    LAS int* tst = (LAS int*)(F.lds + LDS_MISC + 64); LAS int* cntl = tst + 72;
    bf16_t* xres = (bf16_t*)args.out + DM;
#define Hb ((bf16_t*)(F.ws + WS_H))
#define Ob ((bf16_t*)(F.ws + WS_O))
#define Y2 ((bf16_t*)(F.ws + WS_PBUF))
#ifndef REP1
#define REP1 1
#endif
#ifndef REP2
#define REP2 1
#endif
#ifndef REP3
#define REP3 1
#endif
#ifndef REP4N
#define REP4N 1
#endif
#ifndef REP4M
#define REP4M 1
#endif
#ifndef REP7
#define REP7 1
#endif
#ifndef REP8
#define REP8 1
#endif
#ifndef REPN
#define REPN 1
#endif
#ifndef REPR
#define REPR 1
#endif
#ifndef REPS
#define REPS 1
#endif
#ifndef REP0W
#define REP0W 1
#endif
#ifndef PHMASK
#define PHMASK 0x3fff
#endif
#define PHEN(p) (((PHMASK) >> (p)) & 1)
#define IN(k) (lo <= (k) && (k) < hi)
#define SEAM(k) do { if (hi > (k) + 1) xcd_barrier(bar, F.tid == 0); } while (0)
#define PHB() do { F.lane = opq(lane_id()); F.tid = F.wave * 64 + F.lane; F.ws = opq_p(args.ws); } while (0)

#ifndef REPP
#define REPP 1
#endif
    if (PHEN(9) && IN(0)) { PHB(); for (int rep = 0; rep < REPP; ++rep) prologue_phase(F); SEAM(0); }

#pragma unroll 1
    for (int L = 0; L < DEPTH; ++L) {
        const int pb = 1 + 10 * L, j = L >> 1; const bool nsa = (L & 1) == 0;
#ifdef DBG_NO_MLA
        const bool mix_on = nsa;
#elif defined(DBG_NO_NSA)
        const bool mix_on = !nsa;
#else
        const bool mix_on = true;
#endif
#ifdef DBG_NO_MOE
        const bool moe_on = false;
#else
        const bool moe_on = true;
#endif
        if (PHEN(0) && IN(pb)) {
            PHB();
            if (L == 0) compress_bias_reduce(F);
            norm_phase(F, L == 0 ? args.in[0] : nullptr, xres, xres, (L == 0 || !moe_on) ? nullptr : Y2, args.in[1] + L * DM, Hb);
            for (int rep = 1; rep < REPN; ++rep) norm_phase(F, nullptr, xres, xres, nullptr, args.in[1] + L * DM, Hb);
            SEAM(pb);
        }
        if (PHEN(1) && mix_on && IN(pb + 1)) {
            PHB();
            pg8::DenseSched S; pg8::GemmGeo g{DM, DM, DM, 128u};
            if (nsa) { const bf16_t* Wn = (const bf16_t*)(F.ws + WS_NSA_WIN) + (size_t)j * NSA_INP * DM;
                S.init(Hb, DM, Wn, DM, F.ws + WS_PBUF, NSA_INP, 2, T, PC_GT, F.G, F.bid);
                pg8::EpiStoreBf16 E; for (int rep = 0; rep < REP1; ++rep) pg8::gemm_phase<pg8::EpiStoreBf16, pg8::DenseSched, false>(F.lds, opq(F.tid), g, S, E);
                for (int idx = F.bid; idx < 256; idx += F.G) if ((idx >> 3) < 16) narrow_unit<false>(F, Hb, Wn + (size_t)PC_GT * DM, 16 * (idx & 7) + (idx >> 3), j); }
            else { const bf16_t* Wn = (const bf16_t*)(F.ws + WS_MLA_WIN) + (size_t)j * MLA_INP * DM;
                S.init(Hb, DM, Wn, DM, F.ws + WS_PBUF, MLA_INP, 2, T, 512, F.G, F.bid);
                pg8::EpiMlaIn E{F.ws, args.in, j};
                for (int rep = 0; rep < REP1; ++rep) pg8::gemm_phase<pg8::EpiMlaIn, pg8::DenseSched, false>(F.lds, opq(F.tid), g, S, E);
                for (int idx = F.bid; idx < 256; idx += F.G) if ((idx >> 3) < 16) narrow_unit<true>(F, Hb, Wn + (size_t)512 * DM, 16 * (idx & 7) + (idx >> 3), j); }
            SEAM(pb + 1);
        }
        if (PHEN(2) && mix_on && IN(pb + 2)) {
            PHB();
            for (int rep = 0; rep < REP2; ++rep) {
            if (nsa && PHEN(10)) {
                const int ncmp = F.G >= 128 ? 64 : (F.G > 1 ? F.G / 2 : 1);
                if (F.bid < ncmp) {
                    pg8::CmpSched S{(const char*)(F.ws + WS_PBUF), (const char*)(F.ws + WS_CMP_W1T) + (size_t)j * 2 * 256 * 2048 * 2, (char*)(F.ws + WS_HID), ncmp, F.bid};
                    pg8::GemmGeo g{2048, 16 * NSA_INP, 2048, (unsigned)(NSA_INP * 2)}; pg8::EpiCmpGelu E{(const float*)(F.ws + WS_CMPB) + j * 256};
                    pg8::gemm_phase<pg8::EpiCmpGelu, pg8::CmpSched, false, true>(F.lds, opq(F.tid), g, S, E);
                }
                if (F.G == 1 || F.bid >= ncmp) { const int nb = F.G == 1 ? 1 : F.G - ncmp, b0 = F.G == 1 ? 0 : F.bid - ncmp; nsa_post_phase(F, j, b0 * NWAVES + F.wave, nb * NWAVES); }
            } else if (!nsa && PHEN(11)) {
                pg8::MlaUpSched S{(const char*)(F.ws + WS_PBUF), (const char*)(F.ws + WS_MLA_WUQ) + (size_t)j * 1536 * 256 * 2, (const char*)(F.ws + WS_MLA_WUKV) + (size_t)j * 2048 * 256 * 2, F.G, F.vcu};
                pg8::GemmGeo g{256, MLA_INP, 256, 128u};
                pg8::EpiMlaUp E{F.ws, args.in, j};
                pg8::gemm_phase<pg8::EpiMlaUp, pg8::MlaUpSched, false>(F.lds, opq(F.tid), g, S, E);
            }
            }
            SEAM(pb + 2);
        }
        if (PHEN(3) && mix_on && nsa && IN(pb + 3)) { PHB(); for (int rep = 0; rep < REP3; ++rep) cmp2_phase(F, j); SEAM(pb + 3); }
        if (PHEN(4) && mix_on && IN(pb + 4)) { PHB(); if (nsa) { if (PHEN(12)) { F.cv_it = F.bid * NWAVES + F.wave; F.cv_end = 2 * CONV_NIT; F.cv_L = L; nsa_attn_phase<0>(F);
#ifdef PRB_NSA_VAR
            nsa_attn_phase<PRB_NSA_VAR>(F);
#endif
            } } else { if (PHEN(13)) for (int rep = 0; rep < REP4M; ++rep) mla_attn_phase(F); } SEAM(pb + 4); }
        if (PHEN(5) && mix_on && IN(pb + 5)) {
            PHB();
            pg8::DenseSched S; S.init(Ob, DM, (const bf16_t*)(F.ws + (nsa ? WS_NSA_WOUT : WS_MLA_WOUT)) + (size_t)j * DM * DM, DM, xres, XLD, 2, T, DM, F.G, F.bid);
            pg8::GemmGeo g{DM, DM, DM, 128u}; pg8::EpiResidB E;
            pg8::gemm_phase<pg8::EpiResidB, pg8::DenseSched, false>(F.lds, opq(F.tid), g, S, E);
#ifdef PRB_WOUT
            { pg8::DenseSched S2; S2.init(Ob, DM, (const bf16_t*)(F.ws + (nsa ? WS_NSA_WOUT : WS_MLA_WOUT)) + (size_t)j * DM * DM, DM, F.ws + WS_PBUF, DM, 4, T, DM, F.G, F.bid);
              pg8::gemm_phase<pg8::EpiResid, pg8::DenseSched, false>(F.lds, opq(F.tid), g, S2, E); }
#endif
            SEAM(pb + 5);
        }
        if (PHEN(6) && moe_on && IN(pb + 6)) { PHB(); for (int rep = 0; rep < REPR; ++rep) router_phase(F, L, xres, Hb, rep == 0); SEAM(pb + 6); }
        if (PHEN(6) && moe_on && IN(pb + 7)) { PHB(); for (int rep = 0; rep < REPS; ++rep) moe_scatter_phase(F); SEAM(pb + 7); }
        if (PHEN(7) && moe_on && IN(pb + 8)) {
            PHB();
            moe_tables(F, L, tst, cntl);
            pg8::MoeSched S{tst, cntl, (const int*)(F.ws + WS_ROWLIST), (const char*)Hb, (const char*)(F.ws + ((L & 1) ? WS_MOE_W1B : WS_MOE_W1)), (char*)(F.ws + WS_QA), 2, 1, F.G, F.vcu};
            pg8::GemmGeo g{DM, DM, DM, 128u}; pg8::EpiSwiGLU E;
            for (int rep = 0; rep < REP7; ++rep) pg8::gemm_phase<pg8::EpiSwiGLU, pg8::MoeSched, true>(F.lds, opq(F.tid), g, S, E);
            SEAM(pb + 8);
        }
        if (PHEN(8) && moe_on && IN(pb + 9)) {
            PHB();
            moe_tables(F, L, tst, cntl);
            pg8::MoeSched S{tst, cntl, (const int*)(F.ws + WS_ROWLIST), (const char*)(F.ws + WS_QA), (const char*)(F.ws + ((L & 1) ? WS_MOE_W2B : WS_MOE_W2)), (char*)(F.ws + WS_ROWW), 4, 2, F.G, F.vcu};
            pg8::GemmGeo g{MOE_FF, MOE_FF, MOE_FF, 128u}; pg8::EpiMoeOut E{Y2};
            for (int rep = 0; rep < REP8; ++rep) pg8::gemm_phase<pg8::EpiMoeOut, pg8::MoeSched, false>(F.lds, opq(F.tid), g, S, E);
            SEAM(pb + 9);
        }
    }
    if (IN(41)) { PHB();
#ifdef PRB_ROUTER
        router_phase(F, 3, xres, Hb, false);
#endif
#ifdef PRB_GEMM_WIN
        { pg8::DenseSched S; S.init(Hb, DM, (const bf16_t*)(F.ws + WS_NSA_WIN), DM, F.ws + WS_QA, NSA_INP, 2, T, NSA_INP, F.G, F.bid);
          pg8::GemmGeo g{DM, DM, DM, 128u}; pg8::EpiStoreBf16 E; pg8::gemm_phase<pg8::EpiStoreBf16, pg8::DenseSched, false>(F.lds, opq(F.tid), g, S, E); }
#endif
#ifdef PRB_GEMM_WOUT
        { pg8::DenseSched S; S.init(Ob, DM, (const bf16_t*)(F.ws + WS_NSA_WOUT), DM, F.ws + WS_QA, DM, 2, T, DM, F.G, F.bid);
          pg8::GemmGeo g{DM, DM, DM, 128u}; pg8::EpiStoreBf16 E; pg8::gemm_phase<pg8::EpiStoreBf16, pg8::DenseSched, false>(F.lds, opq(F.tid), g, S, E); }
#endif
#ifdef PRB_NSAPOST
        nsa_post_phase(F, 0, F.bid * NWAVES + F.wave, F.G * NWAVES);
#endif
#ifdef PRB_BAR
        for (int rep = 0; rep < 20; ++rep) xcd_barrier(bar, F.tid == 0);
#endif
#ifndef DBG_NO_MOE
 final_phase(F, args.out, (const bf16_t*)(F.ws + WS_PBUF));
#endif
 }
#undef IN
#undef SEAM
#undef Hb
#undef Ob
#undef Y2
}

extern "C" void kernel_launch(void* const* d_in, const int* in_sizes, int n_in, void* d_out, int out_size, void* d_ws, size_t ws_size, hipStream_t stream) {
    static int grid = 0;
    if (grid == 0) {
        if (n_in != 27 || out_size != T * DM || ws_size < WS_END) { fprintf(stderr, "kernel_launch: unexpected problem (n_in %d, out %d, ws %zu)\n", n_in, out_size, ws_size); grid = -1; return; }
        int dev = 0, cus = 0, per_cu = 0;
        if (hipGetDevice(&dev) != hipSuccess || hipDeviceGetAttribute(&cus, hipDeviceAttributeMultiprocessorCount, dev) != hipSuccess) { grid = -1; return; }
        if (hipFuncSetAttribute((const void*)fwd_kernel, hipFuncAttributeMaxDynamicSharedMemorySize, LDS_BYTES) != hipSuccess) { fprintf(stderr, "kernel_launch: hipFuncSetAttribute failed\n"); grid = -1; return; }
        if (hipOccupancyMaxActiveBlocksPerMultiprocessor(&per_cu, (const void*)fwd_kernel, NTHREADS, LDS_BYTES) != hipSuccess || per_cu < 1) { fprintf(stderr, "kernel_launch: occupancy query says %d\n", per_cu); }
        (void)hipGetLastError();
        grid = cus;
    }
    if (grid < 0) return;
    if (hipMemsetAsync((char*)d_ws + WS_CTL, 0, CTL_ZERO_BYTES, stream) != hipSuccess) return;
    Args a{};
    for (int i = 0; i < 27; ++i) a.in[i] = (const float*)d_in[i];
    a.out = (float*)d_out; a.ws = (unsigned char*)d_ws;
#if MK_ONE_LAUNCH
    a.ph_lo = 0; a.ph_hi = N_PHASES;
    hipLaunchKernelGGL(fwd_kernel, dim3(grid), dim3(NTHREADS), LDS_BYTES, stream, a);
#else
    for (int k = 0; k < N_PHASES; ++k) {
        a.ph_lo = k; a.ph_hi = k + 1;
        hipLaunchKernelGGL(fwd_kernel, dim3(grid), dim3(NTHREADS), LDS_BYTES, stream, a);
    }
#endif
}
```

```cpp
#include <hip/hip_runtime.h>
#include <stdint.h>
#include <stdio.h>

#define DI __device__ __forceinline__
#define GAS __attribute__((address_space(1)))
#define LAS __attribute__((address_space(3)))
typedef unsigned short bf16_t;
typedef short bf16x8 __attribute__((ext_vector_type(8)));
typedef short s16x4 __attribute__((ext_vector_type(4)));
typedef short v4i16_t __attribute__((ext_vector_type(4)));
typedef float f32x2 __attribute__((ext_vector_type(2)));
typedef float f32x4 __attribute__((ext_vector_type(4)));
typedef float f32x16 __attribute__((ext_vector_type(16)));
typedef unsigned u32x2 __attribute__((ext_vector_type(2)));
typedef unsigned u32x4 __attribute__((ext_vector_type(4)));
typedef __bf16 bf16x2_t __attribute__((ext_vector_type(2)));

constexpr int BATCH = 4, SEQ = 8192, DM = 1024, T = BATCH * SEQ, DEPTH = 4;
constexpr int NSA_IN = 2608, NSA_INP = 2816;
constexpr int PC_KC = 1024, PC_VC = 1280, PC_KS = 1536, PC_VS = 1792, PC_KW = 2048, PC_VW = 2304, PC_GT = 2560;
constexpr int MLA_IN = 576, MLA_INP = 768;
constexpr int NCMP = 511, NCMPP = 512;
constexpr int NEXP = 64, MOE_FF = 256;
constexpr float RMS_EPS = 1e-6f;
constexpr float LOG2E = 1.4426950408889634f;
constexpr float NSA_QS = 0.125f * LOG2E;
constexpr float MLA_QS = 0.07216878364870322f * LOG2E;
constexpr int NWAVES = 8, NTHREADS = 512;

constexpr size_t MiB = 1u << 20;
constexpr size_t WS_CTL = 0, CTL_ZERO_BYTES = 1 * MiB;
constexpr size_t WS_ROPE = 1 * MiB;
constexpr size_t WS_RW = 3 * MiB;
constexpr size_t WS_CMPB = 5 * MiB;
constexpr size_t WS_NSA_WIN = 6 * MiB;
constexpr size_t WS_NSA_WOUT = 18 * MiB;
constexpr size_t WS_CMP_W1T = 22 * MiB;
constexpr size_t WS_MLA_WIN = 26 * MiB;
constexpr size_t WS_MLA_WUQ = 29 * MiB;
constexpr size_t WS_MLA_WUKV = 31 * MiB;
constexpr size_t WS_MLA_WOUT = 33 * MiB;
constexpr size_t WS_MOE_W1 = 40 * MiB;
constexpr size_t WS_MOE_W2 = 104 * MiB;
constexpr size_t WS_H = 136 * MiB;
constexpr size_t WS_O = 200 * MiB;
constexpr size_t WS_GATES = 264 * MiB;
constexpr size_t WS_HID = 272 * MiB;
constexpr size_t WS_KCMP = 276 * MiB;
constexpr size_t WS_VCMP = 277 * MiB;
constexpr size_t WS_ROUTE = 278 * MiB;
constexpr size_t WS_ROWLIST = 282 * MiB;
constexpr size_t WS_PBUF = 290 * MiB;
constexpr size_t WS_QA = 562 * MiB;
constexpr size_t WS_ROWW = 820 * MiB;
constexpr size_t WS_MOE_W1B = 830 * MiB;
constexpr size_t WS_MOE_W2B = 894 * MiB;
constexpr size_t WS_END = 926 * MiB;
constexpr int CW_BAR = 4096, CW_CNT = 8192;

constexpr int LDS_MISC = 155648;
constexpr int LDS_BYTES = 155648 + 1024;

DI unsigned f2bf(float f) { unsigned u = __builtin_bit_cast(unsigned, f); return (u + 0x7fffu + ((u >> 16) & 1u)) >> 16; }
DI unsigned pk2(float lo, float hi) { f32x2 v = {lo, hi}; bf16x2_t b = __builtin_convertvector(v, bf16x2_t); return __builtin_bit_cast(unsigned, b); }
DI float bf2f(unsigned short h) { return __builtin_bit_cast(float, (unsigned)h << 16); }
DI float bflo(unsigned w) { return __builtin_bit_cast(float, w << 16); }
DI float bfhi(unsigned w) { return __builtin_bit_cast(float, w & 0xffff0000u); }
DI float fast_exp2(float x) { return __builtin_amdgcn_exp2f(x); }
DI float fast_rcp(float x) { return __builtin_amdgcn_rcpf(x); }
#define LDS_WAIT() asm volatile("s_waitcnt lgkmcnt(0)" ::: "memory")
DI unsigned char* opq_p(unsigned char* p) { unsigned long long v = (unsigned long long)p; asm volatile("" : "+s"(v)); return (unsigned char*)v; }
DI int lane_id() { int x; asm volatile("v_mbcnt_lo_u32_b32 %0, -1, 0\n\tv_mbcnt_hi_u32_b32 %0, -1, %0" : "=v"(x)); return x; }
DI float shx(float v, int o) { return __int_as_float(__builtin_amdgcn_ds_bpermute((lane_id() ^ o) << 2, __float_as_int(v))); }
DI float wave_sum(float v) {
#pragma unroll
    for (int o = 1; o < 64; o <<= 1) v += shx(v, o);
    return v;
}
DI int opq(int x) { asm volatile("" : "+v"(x)); return x; }

#define XB_TMO      128
#define XB_XCNT(j)  (256  + 64 * (j))
#define XB_XSUB(j)  (1280 + 64 * (j))
#define XB_XGEN(j)  (2304 + 64 * (j))
#define XB_TOP      3328
#define XB_TOPGEN   3392
#define XCD_BAR_WORDS 3456
#define XB_SPIN_CAP (1u << 18)
DI unsigned xb_ld(unsigned* p)              { return __hip_atomic_load(p, __ATOMIC_RELAXED, __HIP_MEMORY_SCOPE_AGENT); }
DI unsigned xb_add(unsigned* p, unsigned v) { return __hip_atomic_fetch_add(p, v, __ATOMIC_RELAXED, __HIP_MEMORY_SCOPE_AGENT); }
DI unsigned xb_xcc_id() { return (unsigned)__builtin_amdgcn_s_getreg((3 << 11) | 20) & 0xFu; }
#define XB_SPIN(cond, bar) do { unsigned _sp = 0; while (cond) { __builtin_amdgcn_s_sleep(1); \
    if ((++_sp & 255u) == 0u) { if (xb_ld(&(bar)[XB_TMO])) break; if (_sp > XB_SPIN_CAP) { atomicAdd(&(bar)[XB_TMO], 1u); break; } } } } while (0)
struct XcdBarrier { unsigned* bar; unsigned x; volatile LAS unsigned* st; };
DI XcdBarrier xcd_barrier_post(unsigned* bar, volatile LAS unsigned* st, bool t0) {
    XcdBarrier b; b.bar = bar; b.x = xb_xcc_id(); b.st = st;
    if (t0) (void)xb_add(&bar[XB_XCNT(b.x)], 1u);
    return b;
}
DI void xcd_barrier_complete(unsigned* bar, unsigned x, unsigned& nloc, unsigned& nx) {
    const unsigned G = gridDim.x * gridDim.y * gridDim.z;
    unsigned sum, cnt, mine, sp = 0u;
    for (;;) {
        sum = 0u; cnt = 0u; mine = 0u;
#pragma unroll
        for (unsigned j = 0; j < 16; ++j) { const unsigned c = xb_ld(&bar[XB_XCNT(j)]); sum += c; cnt += (c > 0u) ? 1u : 0u; mine = (j == x) ? c : mine; }
        if (sum == G) break;
        __builtin_amdgcn_s_sleep(1);
        if ((++sp & 255u) == 0u) { if (xb_ld(&bar[XB_TMO])) break; if (sp > XB_SPIN_CAP) { atomicAdd(&bar[XB_TMO], 1u); break; } }
    }
    nloc = mine > 0u ? mine : 1u; nx = cnt > 0u ? cnt : 1u;
}
DI void xcd_barrier(const XcdBarrier& b, bool t0) {
    asm volatile("s_waitcnt vmcnt(0)" ::: "memory");
    __syncthreads();
    if (t0) {
        unsigned* bar = b.bar;
        __builtin_amdgcn_s_waitcnt(0);
        unsigned nloc = b.st[0], nx = b.st[1];
        if (nloc == 0u) { xcd_barrier_complete(bar, b.x, nloc, nx); b.st[0] = nloc; b.st[1] = nx; }
        const unsigned old = xb_add(&bar[XB_XSUB(b.x)], 1u);
        const unsigned gen = old / nloc;
        if (old + 1u == (gen + 1u) * nloc) {
            __builtin_amdgcn_fence(__ATOMIC_RELEASE, "agent");
            asm volatile("s_waitcnt vmcnt(0)" ::: "memory");
            const unsigned og = xb_add(&bar[XB_TOP], 1u);
            const unsigned tg = og / nx;
            __builtin_amdgcn_fence(__ATOMIC_ACQUIRE, "agent");
            if (og + 1u == (tg + 1u) * nx) xb_add(&bar[XB_TOPGEN], 1u);
            else XB_SPIN(xb_ld(&bar[XB_TOPGEN]) == tg, bar);
            __builtin_amdgcn_fence(__ATOMIC_ACQUIRE, "wavefront");
            xb_add(&bar[XB_XGEN(b.x)], 1u);
            asm volatile("s_waitcnt vmcnt(0)" ::: "memory");
        } else {
            __builtin_amdgcn_fence(__ATOMIC_ACQUIRE, "agent");
            XB_SPIN(xb_ld(&bar[XB_XGEN(b.x)]) == gen, bar);
            __builtin_amdgcn_fence(__ATOMIC_ACQUIRE, "wavefront");
            asm volatile("s_waitcnt vmcnt(0)" ::: "memory");
        }
    }
    __syncthreads();
}

namespace pg8 {
constexpr int BM = 256, BK = 64, HALF = 128, HTB = HALF * BK * 2, NXCD = 8, WGM = 8;
DI int lds_byte(int r, int c) { const int st = (r >> 4) * 2 + (c >> 5), rr = r & 15, cc = c & 31, ob = rr * 64 + cc * 2; return st * 1024 + (ob ^ (((ob >> 9) & 1) << 5)); }
DI void stage_rc(int b, int& R, int& C) { const int st = b / 1024, sb = b % 1024, swz = sb ^ (((sb >> 9) & 1) << 5); R = (st >> 1) * 16 + swz / 64; C = (st & 1) * 32 + (swz % 64) / 2; }
DI int perm32(int rho) { const int n = rho >> 4, i = rho & 15; return 8 * (i >> 2) + 4 * n + (i & 3); }

struct Unit { const char* A; const char* B; char* out; int ldc; const int* rows; int nvalid; int aux; int row0; };
struct GemmGeo { int K; int lda; int ldb; unsigned kstepA; };

typedef f32x4 Acc[2][2][4][2];

template <class Epi, class Sched, bool GATHER, bool HALFN = false>
DI void gemm_phase(LAS unsigned char* lds, int tid_, const GemmGeo g, const Sched& S, const Epi& E) {
    const int tid = tid_, wid = __builtin_amdgcn_readfirstlane(tid >> 6), lane = tid & 63, wr = wid >> 2, wc = wid & 3, fr = lane & 15, fq = lane >> 4;
    const int K = g.K, nt = K / BK;
    unsigned voffB[2]; unsigned cuA[2][2], nxA[2][2]; int RA[2], CA[2];
    const unsigned hstepA = (unsigned)HALF * (unsigned)g.lda * 2u;
#pragma unroll
    for (int i = 0; i < 2; ++i) { int R, C; stage_rc(tid * 16 + i * 8192, R, C); const int Rb = (R & ~31) + perm32(R & 31);
        RA[i] = R; CA[i] = C; voffB[i] = (unsigned)(Rb * g.ldb + C) * 2u;
        cuA[0][i] = (unsigned)(R * g.lda + C) * 2u; cuA[1][i] = cuA[0][i] + hstepA; nxA[0][i] = cuA[0][i]; nxA[1][i] = cuA[1][i]; }
    const size_t kstepA = g.kstepA, kstepB = (size_t)(BK * 2);
    const size_t hstepB = (size_t)HALF * g.ldb * 2;
    const unsigned ldsw = (unsigned)wid * 1024u;
    const int aoff = lds_byte(wr * 64 + fr, fq * 8), boff = lds_byte(wc * 32 + fr, fq * 8);
#define PG8_SA(b, h) (((b) * 2 + (h)) * HTB)
#define PG8_SB(b, h) ((4 + (b) * 2 + (h)) * HTB)
#define PG8_STAGEB(bufoff, gbase) do { _Pragma("unroll") for (int _i = 0; _i < 2; ++_i) \
        __builtin_amdgcn_global_load_lds((const unsigned*)((const char*)(gbase) + voffB[_i]), (LAS unsigned*)(lds + (bufoff) + ldsw + _i * 8192), 16, 0, 0); } while (0)
#define PG8_STAGEA(bufoff, gbase, o0, o1) do { \
        __builtin_amdgcn_global_load_lds((const unsigned*)((const char*)(gbase) + (o0)), (LAS unsigned*)(lds + (bufoff) + ldsw), 16, 0, 0); \
        __builtin_amdgcn_global_load_lds((const unsigned*)((const char*)(gbase) + (o1)), (LAS unsigned*)(lds + (bufoff) + ldsw + 8192), 16, 0, 0); } while (0)
#define PG8_LDA(dst, b, h) do { _Pragma("unroll") for (int m = 0; m < 4; ++m) _Pragma("unroll") for (int k = 0; k < 2; ++k) dst[m][k] = *(const LAS bf16x8*)(lds + PG8_SA(b, h) + aoff + m * 2048 + k * 1024); } while (0)
#define PG8_LDB(dst, b, h) do { _Pragma("unroll") for (int n = 0; n < 2; ++n) _Pragma("unroll") for (int k = 0; k < 2; ++k) dst[n][k] = *(const LAS bf16x8*)(lds + PG8_SB(b, h) + boff + n * 2048 + k * 1024); } while (0)
#define PG8_MMA(ai, bj, At, Bt) do { __builtin_amdgcn_s_setprio(3); _Pragma("unroll") for (int m = 0; m < 4; ++m) _Pragma("unroll") for (int n = 0; n < 2; ++n) _Pragma("unroll") for (int k = 0; k < 2; ++k) \
        acc[ai][bj][m][n] = __builtin_amdgcn_mfma_f32_16x16x32_bf16(Bt[n][k], At[m][k], acc[ai][bj][m][n], 0, 0, 0); __builtin_amdgcn_s_setprio(0); } while (0)
#define PG8_WAIT_V(n) asm volatile("s_waitcnt vmcnt(" #n ")" ::: "memory")
#define PG8_WAIT_L(n) asm volatile("s_waitcnt lgkmcnt(" #n ")" ::: "memory")
#define PG8_BAR __builtin_amdgcn_s_barrier()
#define PG8_SCHED __builtin_amdgcn_sched_barrier(0)
#define PG8_GOFF(u_, dst) do { if constexpr (GATHER) { _Pragma("unroll") for (int _h = 0; _h < 2; ++_h) _Pragma("unroll") for (int _i = 0; _i < 2; ++_i) { \
        const int _r = RA[_i] + _h * HALF; const int _t = (_r < (u_).nvalid) ? ((u_).rows[_r] >> 1) : 0; dst[_h][_i] = ((unsigned)_t * (unsigned)g.lda + (unsigned)CA[_i]) * 2u; } } } while (0)
    Unit cur, nxt; int ui = 0;
    if (!S.next(0, cur)) return;
    Acc acc;
#pragma unroll
    for (int a = 0; a < 2; ++a)
#pragma unroll
        for (int b = 0; b < 2; ++b)
#pragma unroll
            for (int m = 0; m < 4; ++m)
#pragma unroll
                for (int n = 0; n < 2; ++n) acc[a][b][m][n] = (f32x4){0.f, 0.f, 0.f, 0.f};
    bf16x8 At[4][2], B0[2][2], B1[2][2];
    const char* cA = cur.A; const char* cB = cur.B;
    PG8_GOFF(cur, cuA);
    PG8_STAGEB(PG8_SB(0, 0), cB); PG8_STAGEB(PG8_SB(0, 1), cB + hstepB); PG8_STAGEA(PG8_SA(0, 0), cA, cuA[0][0], cuA[0][1]); PG8_STAGEA(PG8_SA(0, 1), cA, cuA[1][0], cuA[1][1]);
    if (wr == 1) PG8_BAR;
    PG8_WAIT_V(2); PG8_BAR;
    PG8_STAGEB(PG8_SB(1, 0), cB + kstepB); PG8_STAGEA(PG8_SA(1, 0), cA + kstepA, cuA[0][0], cuA[0][1]); PG8_STAGEB(PG8_SB(1, 1), cB + hstepB + kstepB);
    PG8_WAIT_V(6); PG8_BAR;
    for (;;) {
        u32x2 prev = {0u, 0u};
        if constexpr (Epi::PRE) prev = E.pre(cur, tid);
        const bool has_next = S.next(ui + 1, nxt);
        const char* nA = has_next ? nxt.A : cA; const char* nB = has_next ? nxt.B : cB;
        if constexpr (GATHER) { if (has_next) { PG8_GOFF(nxt, nxA); } else {
#pragma unroll
            for (int h = 0; h < 2; ++h)
#pragma unroll
                for (int i = 0; i < 2; ++i) nxA[h][i] = cuA[h][i]; } }
#pragma unroll 1
        for (int t = 0; t < nt; t += 2) {
            const bool last = (t == nt - 2);
            const char* a1 = cA + (size_t)(t + 1) * kstepA;
            const char* a2 = last ? nA : cA + (size_t)(t + 2) * kstepA; const char* b2 = last ? nB : cB + (size_t)(t + 2) * kstepB;
            const char* a3 = a2 + kstepA; const char* b3 = b2 + kstepB;
            unsigned o00, o01, o10, o11;
            if constexpr (GATHER) { o00 = last ? nxA[0][0] : cuA[0][0]; o01 = last ? nxA[0][1] : cuA[0][1]; o10 = last ? nxA[1][0] : cuA[1][0]; o11 = last ? nxA[1][1] : cuA[1][1]; }
            else { o00 = cuA[0][0]; o01 = cuA[0][1]; o10 = cuA[1][0]; o11 = cuA[1][1]; }
            PG8_LDB(B0, 0, 0); if constexpr (!HALFN) PG8_LDB(B1, 0, 1); PG8_SCHED; PG8_LDA(At, 0, 0); PG8_STAGEA(PG8_SA(1, 1), a1, cuA[1][0], cuA[1][1]);
            PG8_WAIT_V(8); PG8_WAIT_L(0); PG8_BAR; PG8_MMA(0, 0, At, B0); if constexpr (!HALFN) PG8_MMA(0, 1, At, B1); PG8_BAR; PG8_SCHED;
            PG8_LDA(At, 0, 1); PG8_STAGEB(PG8_SB(0, 0), b2); PG8_STAGEB(PG8_SB(0, 1), b2 + hstepB); PG8_STAGEA(PG8_SA(0, 0), a2, o00, o01);
            PG8_WAIT_V(8); PG8_WAIT_L(0); PG8_BAR; PG8_MMA(1, 0, At, B0); if constexpr (!HALFN) PG8_MMA(1, 1, At, B1); PG8_BAR; PG8_SCHED;
            PG8_LDB(B0, 1, 0); if constexpr (!HALFN) PG8_LDB(B1, 1, 1); PG8_SCHED; PG8_LDA(At, 1, 0); PG8_STAGEA(PG8_SA(0, 1), a2, o10, o11);
            PG8_WAIT_V(8); PG8_WAIT_L(0); PG8_BAR; PG8_MMA(0, 0, At, B0); if constexpr (!HALFN) PG8_MMA(0, 1, At, B1); PG8_BAR; PG8_SCHED;
            PG8_LDA(At, 1, 1); PG8_STAGEB(PG8_SB(1, 0), b3); PG8_STAGEB(PG8_SB(1, 1), b3 + hstepB); PG8_STAGEA(PG8_SA(1, 0), a3, o00, o01);
            PG8_WAIT_V(8); PG8_WAIT_L(0); PG8_BAR; PG8_MMA(1, 0, At, B0); if constexpr (!HALFN) PG8_MMA(1, 1, At, B1); PG8_BAR; PG8_SCHED;
        }
        if (wr == 0) PG8_BAR;
        if constexpr (Epi::PRE) E(acc, cur, wr, wc, fr, fq, prev, tid); else E(acc, cur, wr, wc, fr, fq);
        if (!has_next) break;
#pragma unroll
        for (int a = 0; a < 2; ++a)
#pragma unroll
            for (int b = 0; b < 2; ++b)
#pragma unroll
                for (int m = 0; m < 4; ++m)
#pragma unroll
                    for (int n = 0; n < 2; ++n) acc[a][b][m][n] = (f32x4){0.f, 0.f, 0.f, 0.f};
        cur = nxt; cA = nA; cB = nB; ++ui;
        if constexpr (GATHER) {
#pragma unroll
            for (int h = 0; h < 2; ++h)
#pragma unroll
                for (int i = 0; i < 2; ++i) cuA[h][i] = nxA[h][i]; }
        if (wr == 1) PG8_BAR;
    }
    PG8_WAIT_V(0);
    PG8_BAR;
#undef PG8_SA
#undef PG8_SB
#undef PG8_STAGEA
#undef PG8_STAGEB
#undef PG8_LDA
#undef PG8_LDB
#undef PG8_MMA
#undef PG8_WAIT_V
#undef PG8_WAIT_L
#undef PG8_BAR
#undef PG8_SCHED
#undef PG8_GOFF
}
}
namespace pg8 {
constexpr int XCH_OFF_ = 131072;
DI u32x4 pack8(const f32x4& a, const f32x4& b) { u32x4 w; w.x = pk2(a[0], a[1]); w.y = pk2(a[2], a[3]); w.z = pk2(b[0], b[1]); w.w = pk2(b[2], b[3]); return w; }

struct EpiStoreBf16 {
    static constexpr bool PRE = false;
    DI void operator()(const Acc& acc, const Unit& u, int wr, int wc, int fr, int fq) const {
        bf16_t* base = (bf16_t*)u.out + (size_t)(wr * 64 + fr) * u.ldc + wc * 32 + 8 * fq;
#pragma unroll
        for (int ai = 0; ai < 2; ++ai)
#pragma unroll
            for (int m = 0; m < 4; ++m) { bf16_t* rowp = base + (size_t)(ai * HALF + m * 16) * u.ldc;
#pragma unroll
                for (int bj = 0; bj < 2; ++bj) *(u32x4*)(rowp + bj * HALF) = pack8(acc[ai][bj][m][0], acc[ai][bj][m][1]); }
    }
};
struct EpiResid {
    static constexpr bool PRE = false;
    DI void operator()(const Acc& acc, const Unit& u, int wr, int wc, int fr, int fq) const {
        float* base = (float*)u.out + (size_t)(wr * 64 + fr) * u.ldc + wc * 32 + 8 * fq;
#pragma unroll
        for (int ai = 0; ai < 2; ++ai)
#pragma unroll
            for (int m = 0; m < 4; ++m) { float* rowp = base + (size_t)(ai * HALF + m * 16) * u.ldc;
#pragma unroll
                for (int bj = 0; bj < 2; ++bj) { f32x4* p = (f32x4*)(rowp + bj * HALF); f32x4 a = p[0], b = p[1]; a = a + acc[ai][bj][m][0]; b = b + acc[ai][bj][m][1]; p[0] = a; p[1] = b; } }
    }
};
struct EpiResidB {
    static constexpr bool PRE = false;
    DI void operator()(const Acc& acc, const Unit& u, int wr, int wc, int fr, int fq) const {
        bf16_t* base = (bf16_t*)u.out + (size_t)(wr * 64 + fr) * u.ldc + wc * 32 + 8 * fq;
#pragma unroll
        for (int ai = 0; ai < 2; ++ai)
#pragma unroll
            for (int m = 0; m < 4; ++m) { bf16_t* rowp = base + (size_t)(ai * HALF + m * 16) * u.ldc;
#pragma unroll
                for (int bj = 0; bj < 2; ++bj) { u32x4* p = (u32x4*)(rowp + bj * HALF); const u32x4 w = *p;
                    f32x4 a = {bflo(w.x), bfhi(w.x), bflo(w.y), bfhi(w.y)}, b = {bflo(w.z), bfhi(w.z), bflo(w.w), bfhi(w.w)};
                    a = a + acc[ai][bj][m][0]; b = b + acc[ai][bj][m][1]; *p = pack8(a, b); } }
    }
};
DI float gelu_tanh(float x) {
    const float z = x + 0.044715f * x * x * x;
    const float e = fast_exp2(-2.0f * 0.7978845608028654f * LOG2E * z);
    return x * fast_rcp(1.0f + e);
}
struct EpiCmpGelu {
    static constexpr bool PRE = false;
    const float* bias;
    DI void operator()(const Acc& acc, const Unit& u, int wr, int wc, int fr, int fq) const {
        bf16_t* base = (bf16_t*)u.out + (size_t)(wr * 64 + fr) * 128 + wc * 32 + 8 * fq;
        const float* bp = bias + u.aux * 128 + wc * 32 + 8 * fq;
        const f32x4 b0 = *(const f32x4*)bp, b1 = *(const f32x4*)(bp + 4);
#pragma unroll
        for (int ai = 0; ai < 2; ++ai)
#pragma unroll
            for (int m = 0; m < 4; ++m) { f32x4 v0 = acc[ai][0][m][0] + b0, v1 = acc[ai][0][m][1] + b1;
#pragma unroll
                for (int i = 0; i < 4; ++i) { v0[i] = gelu_tanh(v0[i]); v1[i] = gelu_tanh(v1[i]); }
                *(u32x4*)(base + (size_t)(ai * HALF + m * 16) * 128) = pack8(v0, v1); }
    }
};
struct EpiSwiGLU {
    static constexpr bool PRE = false;
    DI void operator()(const Acc& acc, const Unit& u, int wr, int wc, int fr, int fq) const {
        bf16_t* base = (bf16_t*)u.out + (size_t)(wr * 64 + fr) * MOE_FF + wc * 32 + 8 * fq;
#pragma unroll
        for (int ai = 0; ai < 2; ++ai)
#pragma unroll
            for (int m = 0; m < 4; ++m) { f32x4 h0, h1;
#pragma unroll
                for (int i = 0; i < 4; ++i) { const float g0 = acc[ai][0][m][0][i], g1 = acc[ai][0][m][1][i];
                    h0[i] = g0 * fast_rcp(1.0f + fast_exp2(-LOG2E * g0)) * acc[ai][1][m][0][i];
                    h1[i] = g1 * fast_rcp(1.0f + fast_exp2(-LOG2E * g1)) * acc[ai][1][m][1][i]; }
                *(u32x4*)(base + (size_t)(ai * HALF + m * 16) * MOE_FF) = pack8(h0, h1); }
    }
};
struct EpiMoeOut {
    static constexpr bool PRE = true;
    bf16_t* y2;
    DI u32x2 pre(const Unit& u, int tid) const { u32x2 r = {0u, 0u};
        if (tid < u.nvalid) { r.x = (unsigned)u.rows[tid]; r.y = __float_as_uint(((const float*)u.out)[tid]); } return r; }
    DI void operator()(const Acc& acc, const Unit& u, int wr, int wc, int fr, int fq, u32x2 pv, int tid) const {
        LAS u32x2* Tb = (LAS u32x2*)XCH_OFF_;
        if (tid < 256) Tb[tid] = pv;
        asm volatile("s_waitcnt lgkmcnt(0)\n\ts_barrier" ::: "memory");
#pragma unroll
        for (int ai = 0; ai < 2; ++ai)
#pragma unroll
            for (int m = 0; m < 4; ++m) { const int r = ai * HALF + wr * 64 + m * 16 + fr;
                if (r < u.nvalid) { const u32x2 e = Tb[r]; const int a = (int)e.x; const float w = __uint_as_float(e.y);
                    bf16_t* dst = y2 + (size_t)a * DM + u.aux + wc * 32 + 8 * fq;
#pragma unroll
                    for (int bj = 0; bj < 2; ++bj) { f32x4 v0 = acc[ai][bj][m][0] * w, v1 = acc[ai][bj][m][1] * w; *(u32x4*)(dst + bj * HALF) = pack8(v0, v1); } } }
    }
};

constexpr int XCH_OFF = 131072;
DI void epi_bar() { asm volatile("s_waitcnt lgkmcnt(0)\n\ts_barrier" ::: "memory"); }
DI float sq4(const f32x4& a) { return (a[0] * a[0] + a[1] * a[1]) + (a[2] * a[2] + a[3] * a[3]); }
DI float fq_sum(float s) {
    auto a = __builtin_amdgcn_permlane16_swap(__float_as_uint(s), __float_as_uint(s), false, false); s = __uint_as_float(a[0]) + __uint_as_float(a[1]);
    auto b = __builtin_amdgcn_permlane32_swap(__float_as_uint(s), __float_as_uint(s), false, false); return __uint_as_float(b[0]) + __uint_as_float(b[1]);
}
DI u32x2 pack4(const f32x4& a) { u32x2 w; w.x = pk2(a[0], a[1]); w.y = pk2(a[2], a[3]); return w; }
struct EpiMlaIn {
    static constexpr bool PRE = false;
    unsigned char* ws; const float* const* in; int j;
    DI void operator()(const Acc& acc, const Unit& u, int wr, int wc, int fr, int fq) const {
        fr = opq(fr); fq = opq(fq);
        const int pn = u.aux;
        bf16_t* C1 = (bf16_t*)(ws + WS_PBUF); float* rq = (float*)(ws + WS_GATES); float* rkv = (float*)(ws + WS_GATES + MiB); bf16_t* kr = (bf16_t*)(ws + WS_HID);
        const float* ct = (const float*)(ws + WS_ROPE); const float* st = ct + SEQ * 32; LAS float* X = (LAS float*)XCH_OFF;
        if (pn < 2) {
            bf16_t* base = C1 + (size_t)(u.row0 + wr * 64 + fr) * MLA_INP + pn * 256 + wc * 32 + 8 * fq;
#pragma unroll
            for (int ai = 0; ai < 2; ++ai)
#pragma unroll
                for (int m = 0; m < 4; ++m) { bf16_t* rowp = base + (size_t)(ai * HALF + m * 16) * MLA_INP;
#pragma unroll
                    for (int bj = 0; bj < 2; ++bj) *(u32x4*)(rowp + bj * HALF) = pack8(acc[ai][bj][m][0], acc[ai][bj][m][1]);
                    const float sp = fq_sum((sq4(acc[ai][0][m][0]) + sq4(acc[ai][0][m][1])) + (sq4(acc[ai][1][m][0]) + sq4(acc[ai][1][m][1])));
                    if (fq == 0) X[(ai * HALF + wr * 64 + m * 16 + fr) * 8 + wc] = sp; }
            epi_bar();
            if (wc == 0 && fq == 0) { float* dst = pn == 0 ? rq : rkv;
#pragma unroll
                for (int ai = 0; ai < 2; ++ai)
#pragma unroll
                    for (int m = 0; m < 4; ++m) { const int r = ai * HALF + wr * 64 + m * 16 + fr; const f32x4 pp = *(const LAS f32x4*)(X + r * 8);
                        dst[u.row0 + r] = __builtin_amdgcn_rsqf(((pp[0] + pp[1]) + (pp[2] + pp[3])) * (1.0f / 256.0f) + RMS_EPS); } }
        } else {
#pragma unroll
            for (int ai = 0; ai < 2; ++ai)
#pragma unroll
                for (int m = 0; m < 4; ++m) { const float sp = fq_sum(wc < 2 ? sq4(acc[ai][0][m][0]) + sq4(acc[ai][0][m][1]) : 0.f);
                    if (fq == 0 && wc < 2) X[(ai * HALF + wr * 64 + m * 16 + fr) * 8 + wc] = sp; }
            epi_bar();
            if (wc < 2) { const float* gkr = in[18] + j * 64; const int d0 = 4 * (4 * wc + fq); const f32x4 g1 = *(const f32x4*)(gkr + d0), g2 = *(const f32x4*)(gkr + 32 + d0);
#pragma unroll
                for (int ai = 0; ai < 2; ++ai)
#pragma unroll
                    for (int m = 0; m < 4; ++m) { const int r = ai * HALF + wr * 64 + m * 16 + fr; const int grow = u.row0 + r, t = grow & (SEQ - 1);
                        const float rs = __builtin_amdgcn_rsqf((X[r * 8] + X[r * 8 + 1]) * (1.0f / 64.0f) + RMS_EPS);
                        const f32x4 c4 = *(const f32x4*)(ct + t * 32 + d0), s4 = *(const f32x4*)(st + t * 32 + d0);
                        const f32x4 x1 = acc[ai][0][m][0] * rs * g1, x2 = acc[ai][0][m][1] * rs * g2;
                        const f32x4 o1 = x1 * c4 - x2 * s4, o2 = x2 * c4 + x1 * s4;
                        *(u32x2*)(kr + (size_t)grow * 64 + d0) = pack4(o1); *(u32x2*)(kr + (size_t)grow * 64 + 32 + d0) = pack4(o2); } }
        }
    }
};
struct EpiMlaUp {
    static constexpr bool PRE = false;
    unsigned char* ws; const float* const* in; int j;
    DI void operator()(const Acc& acc, const Unit& u, int wr, int wc, int fr, int fq) const {
        fr = opq(fr); fq = opq(fq);
        const int aux = u.aux;
        LAS float* X = (LAS float*)XCH_OFF;
        bf16_t* Qf = (bf16_t*)(ws + WS_QA); bf16_t* Kn = Qf + (size_t)T * 1536; bf16_t* Vf = Kn + (size_t)T * DM;
        const float* rl = (const float*)(ws + WS_GATES + (aux < 6 ? 0 : MiB));
        float rlat[2][4];
#pragma unroll
        for (int ai = 0; ai < 2; ++ai)
#pragma unroll
            for (int m = 0; m < 4; ++m) rlat[ai][m] = rl[u.row0 + ai * HALF + wr * 64 + m * 16 + fr];
        const int cb = wc * 32 + 8 * fq;
        const bool kv = aux >= 6;
#pragma unroll
        for (int ai = 0; ai < 2; ++ai)
#pragma unroll
            for (int m = 0; m < 4; ++m) { const float rr = rlat[ai][m] * rlat[ai][m]; const int r = ai * HALF + wr * 64 + m * 16 + fr;
                const float s0 = fq_sum((sq4(acc[ai][0][m][0]) + sq4(acc[ai][0][m][1])) * rr);
                const float s1 = fq_sum((sq4(acc[ai][1][m][0]) + sq4(acc[ai][1][m][1])) * rr);
                if (fq == 0) { X[r * 8 + wc] = s0; X[r * 8 + 4 + wc] = s1; } }
        epi_bar();
        if (aux < 4 || kv) {
            const float* g = (kv ? in[17] : in[15]) + j * 128; const f32x4 g0 = *(const f32x4*)(g + cb), g1 = *(const f32x4*)(g + cb + 4);
            const float qs = kv ? 1.0f : MLA_QS;
#pragma unroll
            for (int ai = 0; ai < 2; ++ai)
#pragma unroll
                for (int m = 0; m < 4; ++m) { const int r = ai * HALF + wr * 64 + m * 16 + fr; const size_t grow = (size_t)(u.row0 + r);
                    const f32x4 pa = *(const LAS f32x4*)(X + r * 8), pb = *(const LAS f32x4*)(X + r * 8 + 4);
                    const float rsA = rlat[ai][m] * __builtin_amdgcn_rsqf(((pa[0] + pa[1]) + (pa[2] + pa[3])) * (1.0f / 128.0f) + RMS_EPS) * qs;
                    const f32x4 a0 = acc[ai][0][m][0] * rsA * g0, a1 = acc[ai][0][m][1] * rsA * g1;
                    if (!kv) {
                        const float rsB = rlat[ai][m] * __builtin_amdgcn_rsqf(((pb[0] + pb[1]) + (pb[2] + pb[3])) * (1.0f / 128.0f) + RMS_EPS) * qs;
                        const f32x4 b0 = acc[ai][1][m][0] * rsB * g0, b1 = acc[ai][1][m][1] * rsB * g1;
                        *(u32x4*)(Qf + grow * 1536 + (2 * aux) * 192 + cb) = pack8(a0, a1);
                        *(u32x4*)(Qf + grow * 1536 + (2 * aux + 1) * 192 + cb) = pack8(b0, b1);
                    } else {
                        const f32x4 b0 = acc[ai][1][m][0] * rlat[ai][m], b1 = acc[ai][1][m][1] * rlat[ai][m];
                        *(u32x4*)(Kn + grow * DM + (aux - 6) * 128 + cb) = pack8(a0, a1);
                        *(u32x4*)(Vf + grow * DM + (aux - 6) * 128 + cb) = pack8(b0, b1);
                    } }
        } else {
            const float* gqr = in[16] + j * 64; const float* ct = (const float*)(ws + WS_ROPE); const float* st = ct + SEQ * 32;
            const int d0 = 4 * (4 * (wc & 1) + fq); const f32x4 g1 = *(const f32x4*)(gqr + d0), g2 = *(const f32x4*)(gqr + 32 + d0);
#pragma unroll
            for (int ai = 0; ai < 2; ++ai)
#pragma unroll
                for (int m = 0; m < 4; ++m) { const int r = ai * HALF + wr * 64 + m * 16 + fr; const size_t grow = (size_t)(u.row0 + r); const int t = (int)grow & (SEQ - 1);
                    const f32x4 c4 = *(const f32x4*)(ct + t * 32 + d0), s4 = *(const f32x4*)(st + t * 32 + d0);
#pragma unroll
                    for (int bj = 0; bj < 2; ++bj) { const float tot = X[r * 8 + bj * 4 + (wc & 2)] + X[r * 8 + bj * 4 + (wc & 2) + 1];
                        const float rs = rlat[ai][m] * __builtin_amdgcn_rsqf(tot * (1.0f / 64.0f) + RMS_EPS) * MLA_QS;
                        const f32x4 x1 = acc[ai][bj][m][0] * rs * g1, x2 = acc[ai][bj][m][1] * rs * g2;
                        const f32x4 o1 = x1 * c4 - x2 * s4, o2 = x2 * c4 + x1 * s4;
                        bf16_t* dst = Qf + grow * 1536 + ((aux - 4) * 4 + 2 * bj + (wc >> 1)) * 192 + 128 + d0;
                        *(u32x2*)dst = pack4(o1); *(u32x2*)(dst + 32) = pack4(o2); } }
        }
    }
};

struct DenseSched {
    const char* A; const char* B; char* out; int lda, ldb, ldc, esz; int nM, nN, nwg, G, c;
    DI void init(const void* A_, int lda_, const void* B_, int ldb_, void* out_, int ldc_, int esz_, int M, int N, int G_, int c_) {
        A = (const char*)A_; B = (const char*)B_; out = (char*)out_; lda = lda_; ldb = ldb_; ldc = ldc_; esz = esz_; nM = M / BM; nN = N / BM; nwg = nM * nN; G = G_; c = c_; }
    DI bool next(int i, Unit& u) const {
        const long L = (long)i * G + c; if (L >= nwg) return false;
        int wgid = (int)L; { const int q = nwg / NXCD, r = nwg % NXCD, xcd = wgid % NXCD, off = wgid / NXCD; wgid = (xcd < r ? xcd * (q + 1) : r * (q + 1) + (xcd - r) * q) + off; }
        const int nig = WGM * nN, gid = wgid / nig, fm = gid * WGM, gsz = (nM - fm) < WGM ? (nM - fm) : WGM;
        const int pm = fm + ((wgid % nig) % gsz), pn = (wgid % nig) / gsz;
        u.A = A + (size_t)pm * BM * lda * 2; u.B = B + (size_t)pn * BM * ldb * 2; u.out = out + ((size_t)pm * BM * ldc + (size_t)pn * BM) * esz; u.ldc = ldc; u.rows = nullptr; u.nvalid = BM; u.aux = pn; u.row0 = pm * BM;
        return true;
    }
};
struct MlaUpSched {
    const char* C1; const char* Wq; const char* Wkv; int G, c;
    DI bool next(int i, Unit& u) const {
        const int L = i * G + c; if (L >= 128 * 14) return false;
        const int pm = L / 14, idx = L % 14; const bool kv = idx >= 6; const int pn = kv ? idx - 6 : idx;
        u.A = C1 + ((size_t)pm * BM * MLA_INP + (kv ? 256 : 0)) * 2;
        u.B = (kv ? Wkv : Wq) + (size_t)pn * BM * 256 * 2;
        u.ldc = 0; u.out = nullptr; u.rows = nullptr; u.nvalid = BM; u.aux = idx; u.row0 = pm * BM;
        return true;
    }
};
struct CmpSched {
    const char* P; const char* W1T; char* HID; int nblk, c;
    DI bool next(int i, Unit& u) const {
        const int L = i * nblk + c; if (L >= 64) return false;
        const int rt = L & 1, g = (L >> 1) & 3, b = (L >> 3) & 3, kv = L >> 5;
        u.A = P + (((size_t)b * SEQ + (size_t)4096 * rt) * NSA_INP + (kv ? PC_VC : PC_KC) + 64 * g) * 2;
        u.B = W1T + (size_t)kv * 256 * 2048 * 2;
        u.out = HID + ((((size_t)kv * 4 + b) * 4 + g) * NCMPP + 256 * rt) * 128 * 2; u.ldc = 128; u.rows = nullptr; u.nvalid = BM; u.aux = kv; u.row0 = 0;
        return true;
    }
};
struct MoeSched {
    LAS const int* tstart; LAS const int* cnt; const int* rowlist; const char* A; const char* B; char* out; int npn, mode, G, c;
    int base, lim, k, R1;
    DI bool next(int i, Unit& u) const {
        int L;
        if (i < k) L = i * G + c; else { if (c < R1) return false; L = k * G + (i - k) * (G - R1) + (c - R1); }
        L += base;
        const int ntot = tstart[NEXP] * npn; if (L >= ntot || L >= lim) return false;
        const int ti = L / npn, pn = L % npn;
        int e = 0;
#pragma unroll 1
        for (int s = 32; s > 0; s >>= 1) { if (tstart[e + s] <= ti) e += s; }
        const int pm = ti - tstart[e];
        u.row0 = 0; u.rows = rowlist + (size_t)e * T + pm * BM; { const int left = cnt[e] - pm * BM; u.nvalid = left < BM ? left : BM; }
        if (mode == 1) { u.A = A; u.B = B + ((size_t)e * 512 + (size_t)pn * BM) * DM * 2; u.out = out + ((size_t)ti * BM * MOE_FF + (size_t)pn * HALF) * 2; u.ldc = MOE_FF; u.aux = 0; }
        else { u.A = A + (size_t)ti * BM * MOE_FF * 2; u.B = B + ((size_t)e * DM + (size_t)pn * BM) * MOE_FF * 2; u.out = out + ((size_t)e * T + pm * BM) * 4; u.ldc = DM; u.aux = pn * BM; }
        return true;
    }
};
}
struct Frame {
    LAS unsigned char* lds;
    unsigned char* ws;
    const float* const* in;
    int tid, lane, wave, G, bid, vcu;
    int cv_it, cv_end, cv_L;
};

DI int mla_invpos(int c) { const int w = c >> 5, fq = (c >> 3) & 3, h2 = (c >> 2) & 1, i = c & 3; return 32 * h2 + 4 * (4 * w + fq) + i; }
DI int srccol(int mode, int rho) {
    if (mode == 1) { if (rho < 1024) { const int head = 2 * (rho >> 8) + ((rho >> 7) & 1); return head * 192 + (rho & 127); }
                     const int q = rho - 1024; const int head = 4 * (q >> 8) + ((q >> 6) & 3); return head * 192 + 128 + mla_invpos(q & 63); }
    if (mode == 2) { if (rho < 512) return rho; if (rho < 576) return 512 + mla_invpos(rho - 512); return -1; }
    return rho;
}
DI void transpose_item(const float* src, int ld, int K, int nvalid, bf16_t* dst, const float* gain, LAS float* scr, int kb, int nb, int lane, int mode = 0) {
    const int k0 = 64 * kb, n0 = 32 * nb;
    const int nn = srccol(mode, n0 + (lane & 31)); const bool ok = nn >= 0 && nn < nvalid;
#pragma unroll 32
    for (int i = 0; i < 32; ++i) { const int kk = 2 * i + (lane >> 5); float v = ok ? src[(size_t)(k0 + kk) * ld + nn] : 0.f; if (gain) v *= gain[k0 + kk]; scr[kk * 33 + (lane & 31)] = v; }
    LDS_WAIT();
    const int c = lane & 7;
#pragma unroll
    for (int j = 0; j < 4; ++j) { const int n = (lane >> 3) + 8 * j; const LAS float* s = scr + (8 * c) * 33 + n;
        u32x4 o; o.x = pk2(s[0 * 33], s[1 * 33]); o.y = pk2(s[2 * 33], s[3 * 33]); o.z = pk2(s[4 * 33], s[5 * 33]); o.w = pk2(s[6 * 33], s[7 * 33]);
        *(u32x4*)(dst + (size_t)(n0 + n) * K + k0 + 8 * c) = o; }
    LDS_WAIT();
}

DI void prologue_phase(Frame& F) {
    LAS float* scr = (LAS float*)(F.lds + F.wave * 16384);
    const int gw = F.bid * NWAVES + F.wave, NGW = F.G * NWAVES, lane = F.lane;
    unsigned char* ws = F.ws;
    constexpr int I_A = 16 * 88, I_B = 16 * 32, I_C = 32 * 8, I_D = 16 * 24, I_E = 4 * 48, I_F = 4 * 64, I_G = 16 * 32;
    constexpr int PERJ = I_A + I_B + 2 * I_C + I_D + I_E + I_F + I_G;
    for (int it = gw; it < 2 * PERJ; it += NGW) {
        const int j = it / PERJ; int r = it % PERJ;
        if (r < I_A) { transpose_item(F.in[3] + (size_t)j * DM * NSA_IN, NSA_IN, DM, NSA_IN, (bf16_t*)(ws + WS_NSA_WIN) + (size_t)j * NSA_INP * DM, nullptr, scr, r / 88, r % 88, lane); continue; } r -= I_A;
        if (r < I_B) { transpose_item(F.in[9] + (size_t)j * DM * DM, DM, DM, DM, (bf16_t*)(ws + WS_NSA_WOUT) + (size_t)j * DM * DM, nullptr, scr, r / 32, r % 32, lane); continue; } r -= I_B;
        if (r < 2 * I_C) { const int kv = r / I_C; r %= I_C;
            transpose_item(F.in[5] + (size_t)(j * 2 + kv) * 2048 * 128, 128, 2048, 128, (bf16_t*)(ws + WS_CMP_W1T) + (size_t)(j * 2 + kv) * 256 * 2048, nullptr, scr, r / 8, r % 8, lane); continue; } r -= 2 * I_C;
        if (r < I_D) { transpose_item(F.in[10] + (size_t)j * DM * MLA_IN, MLA_IN, DM, MLA_IN, (bf16_t*)(ws + WS_MLA_WIN) + (size_t)j * MLA_INP * DM, nullptr, scr, r / 24, r % 24, lane, 2); continue; } r -= I_D;
        if (r < I_E) { transpose_item(F.in[13] + (size_t)j * 256 * 1536, 1536, 256, 1536, (bf16_t*)(ws + WS_MLA_WUQ) + (size_t)j * 1536 * 256, F.in[11] + j * 256, scr, r / 48, r % 48, lane, 1); continue; } r -= I_E;
        if (r < I_F) { transpose_item(F.in[14] + (size_t)j * 256 * 2048, 2048, 256, 2048, (bf16_t*)(ws + WS_MLA_WUKV) + (size_t)j * 2048 * 256, F.in[12] + j * 256, scr, r / 64, r % 64, lane); continue; } r -= I_F;
        transpose_item(F.in[19] + (size_t)j * DM * DM, DM, DM, DM, (bf16_t*)(ws + WS_MLA_WOUT) + (size_t)j * DM * DM, nullptr, scr, r / 32, r % 32, lane);
    }
    {
        float* ct = (float*)(ws + WS_ROPE); float* st = ct + SEQ * 32;
        const int gt = F.bid * NTHREADS + F.tid, NT_ = F.G * NTHREADS;
        for (int e = gt; e < SEQ * 32; e += NT_) { const int t = e >> 5, i = e & 31;
            const float inv = 1.0f / powf(10000.0f, (float)(2 * i) / 64.0f);
            const float ang = (float)t * inv;
            ct[e] = cosf(ang); st[e] = sinf(ang); }
        bf16_t* rwh = (bf16_t*)(ws + WS_RW); bf16_t* rwl = (bf16_t*)(ws + WS_RW + 1 * MiB);
        for (int e = gt; e < 4 * 96 * DM; e += NT_) { const int k = e & 1023, o = (e >> 10) % 96, L = e / (96 * DM);
            float w = 0.f;
            if (o < 8) w = F.in[20][((size_t)L * DM + k) * 8 + o]; else if (o < 72) w = F.in[22][((size_t)L * DM + k) * 64 + (o - 8)];
            w *= F.in[2][L * DM + k];
            const unsigned h = f2bf(w); const float rem = w - bf2f((unsigned short)h);
            const size_t d = (size_t)L * 96 * DM + ((size_t)((k >> 4) * 3 + (o >> 5)) * 64 + ((k >> 3) & 1) * 32 + (o & 31)) * 8 + (k & 7);
            rwh[d] = (bf16_t)h; rwl[d] = (bf16_t)f2bf(rem); }
        for (int u = F.bid; u < 64; u += F.G) { const int jk = u >> 4, h = F.tid & 127, q = F.tid >> 7, k0 = (u & 15) * 128 + q * 32;
            const float* pos = F.in[4] + (size_t)jk * 2048 + k0; const float* w1 = F.in[5] + ((size_t)jk * 2048 + k0) * 128 + h;
            float s = 0.f;
#pragma unroll 8
            for (int k = 0; k < 32; ++k) s += pos[k] * w1[(size_t)k * 128];
            ((float*)(ws + WS_CMPB + 512 * 1024))[(jk * 64 + (u & 15) * 4 + q) * 128 + h] = s; }
    }
}

DI void compress_bias_reduce(Frame& F) {
    for (int gw = F.bid * NWAVES + F.wave; gw < 512; gw += F.G * NWAVES) { const int jk = gw >> 7, h = gw & 127;
        const float v = wave_sum(((const float*)(F.ws + WS_CMPB + 512 * 1024))[(jk * 64 + F.lane) * 128 + h]);
        if (F.lane == 0) ((float*)(F.ws + WS_CMPB))[gw] = v; }
}

DI void glds16(const void* g, LAS void* l) { __builtin_amdgcn_global_load_lds((const unsigned*)g, (LAS unsigned*)l, 16, 0, 0); }
struct ConvItem { const float* src; bf16_t* dst; int ld, K; };
DI ConvItem moe_conv_item(const float* const* in, bf16_t* W1, bf16_t* W2, int L, int it) {
    const int e = it / 384; int r = it % 384; ConvItem c;
    if (r < 256) { const int up = r >> 7; r &= 127; const int kb = r >> 3, nb = r & 7, n0 = 32 * nb;
        c.src = in[up ? 25 : 24] + ((size_t)L * NEXP + e) * DM * MOE_FF + (size_t)(64 * kb) * MOE_FF + n0; c.ld = MOE_FF; c.K = DM;
        c.dst = W1 + ((size_t)e * 512 + 256 * (n0 >> 7) + 128 * up + (n0 & 127)) * DM + 64 * kb; }
    else { r -= 256; const int kb = r >> 5, nb = r & 31;
        c.src = in[26] + ((size_t)L * NEXP + e) * MOE_FF * DM + (size_t)(64 * kb) * DM + 32 * nb; c.ld = DM; c.K = MOE_FF;
        c.dst = W2 + (size_t)e * DM * MOE_FF + (size_t)(32 * nb) * MOE_FF + 64 * kb; }
    return c;
}
DI void conv_issue(const ConvItem& c, LAS unsigned char* scr, int lane) {
    const float* g = c.src + (size_t)(lane >> 3) * c.ld;
#pragma unroll
    for (int i = 0; i < 8; ++i) glds16(g + (size_t)(8 * i) * c.ld + 4 * (((lane & 7) - i) & 7), scr + i * 1024);
}
DI void conv_finish(const ConvItem& c, const LAS unsigned char* scr, int lane) {
    const int cc = lane & 7, nl = lane >> 3;
    const LAS float* sf = (const LAS float*)scr + cc * 256;
#pragma unroll
    for (int j = 0; j < 4; ++j) { const int n = nl + 8 * j; const LAS float* s = sf + ((((n >> 2) + cc) & 7) << 2) + (n & 3);
        u32x4 o; o.x = pk2(s[0], s[32]); o.y = pk2(s[64], s[96]); o.z = pk2(s[128], s[160]); o.w = pk2(s[192], s[224]);
        *(u32x4*)(c.dst + (size_t)n * c.K + 8 * cc) = o; }
}
constexpr int CONV_NIT = NEXP * 384;
DI ConvItem conv_item2(const float* const* in, unsigned char* ws, int Lb, int it) {
    const bool second = it >= CONV_NIT;
    return moe_conv_item(in, (bf16_t*)(ws + (second ? WS_MOE_W1B : WS_MOE_W1)), (bf16_t*)(ws + (second ? WS_MOE_W2B : WS_MOE_W2)), Lb + (second ? 1 : 0), second ? it - CONV_NIT : it);
}

constexpr int XLD = 2 * DM;
DI void norm_phase(Frame& F, const float* xf32, const bf16_t* xsrc, bf16_t* xdst, const bf16_t* y2, const float* g, bf16_t* h) {
    const int gw = F.bid * NWAVES + F.wave, NGW = F.G * NWAVES, lane = F.lane;
    f32x4 gv[4];
#pragma unroll
    for (int j = 0; j < 4; ++j) gv[j] = g ? *(const f32x4*)(g + 4 * lane + 256 * j) : (f32x4){1.f, 1.f, 1.f, 1.f};
#pragma unroll 2
    for (int row = gw; row < T; row += NGW) {
        f32x4 v[4];
        if (xf32) { const f32x4* xr = (const f32x4*)(xf32 + (size_t)row * DM) + lane;
#pragma unroll
            for (int j = 0; j < 4; ++j) v[j] = xr[64 * j];
        } else { const u32x2* xr = (const u32x2*)(xsrc + (size_t)row * XLD) + lane;
#pragma unroll
            for (int j = 0; j < 4; ++j) { const u32x2 a = xr[64 * j]; v[j][0] = bflo(a.x); v[j][1] = bfhi(a.x); v[j][2] = bflo(a.y); v[j][3] = bfhi(a.y); } }
        if (y2) {
            const u32x2* y0 = (const u32x2*)(y2 + (size_t)row * 2 * DM) + lane; const u32x2* y1 = y0 + DM / 4;
#pragma unroll
            for (int j = 0; j < 4; ++j) { const u32x2 a = y0[64 * j], b = y1[64 * j];
                v[j][0] += bflo(a.x) + bflo(b.x); v[j][1] += bfhi(a.x) + bfhi(b.x); v[j][2] += bflo(a.y) + bflo(b.y); v[j][3] += bfhi(a.y) + bfhi(b.y); }
        }
        u32x2* xo = (u32x2*)(xdst + (size_t)row * XLD) + lane;
#pragma unroll
        for (int j = 0; j < 4; ++j) { u32x2 o; o.x = pk2(v[j][0], v[j][1]); o.y = pk2(v[j][2], v[j][3]); xo[64 * j] = o; }
        if (h) {
            float ss = 0.f;
#pragma unroll
            for (int j = 0; j < 4; ++j) ss += (v[j][0] * v[j][0] + v[j][1] * v[j][1]) + (v[j][2] * v[j][2] + v[j][3] * v[j][3]);
            ss = wave_sum(ss);
            const float rstd = 1.0f / sqrtf(ss * (1.0f / DM) + RMS_EPS);
            u32x2* ho = (u32x2*)(h + (size_t)row * DM) + lane;
#pragma unroll
            for (int j = 0; j < 4; ++j) { u32x2 o; o.x = pk2(v[j][0] * rstd * gv[j][0], v[j][1] * rstd * gv[j][1]); o.y = pk2(v[j][2] * rstd * gv[j][2], v[j][3] * rstd * gv[j][3]); ho[64 * j] = o; }
        }
    }
}
DI void final_phase(Frame& F, float* out, const bf16_t* y2) {
    const int gw = F.bid * NWAVES + F.wave, NGW = F.G * NWAVES, lane = F.lane;
#pragma unroll 1
    for (int row = gw; row < T; row += NGW) {
        f32x4 v[4];
        const u32x2* xr = (const u32x2*)((const bf16_t*)out + (size_t)row * XLD + DM) + lane;
        const u32x2* y0 = (const u32x2*)(y2 + (size_t)row * 2 * DM) + lane; const u32x2* y1 = y0 + DM / 4;
        u32x2 xa[4], ya[4], yb[4];
#pragma unroll
        for (int j = 0; j < 4; ++j) { xa[j] = xr[64 * j]; ya[j] = y0[64 * j]; yb[j] = y1[64 * j]; }
        asm volatile("s_waitcnt vmcnt(0)" ::: "memory");
        __builtin_amdgcn_sched_barrier(0);
#pragma unroll
        for (int j = 0; j < 4; ++j) { v[j][0] = bflo(xa[j].x) + (bflo(ya[j].x) + bflo(yb[j].x)); v[j][1] = bfhi(xa[j].x) + (bfhi(ya[j].x) + bfhi(yb[j].x));
            v[j][2] = bflo(xa[j].y) + (bflo(ya[j].y) + bflo(yb[j].y)); v[j][3] = bfhi(xa[j].y) + (bfhi(ya[j].y) + bfhi(yb[j].y)); }
        f32x4* xo = (f32x4*)(out + (size_t)row * DM) + lane;
#pragma unroll
        for (int j = 0; j < 4; ++j) xo[64 * j] = v[j];
    }
}

DI void unpack8(const u32x4& w, float* f) { f[0] = bflo(w.x); f[1] = bfhi(w.x); f[2] = bflo(w.y); f[3] = bfhi(w.y); f[4] = bflo(w.z); f[5] = bfhi(w.z); f[6] = bflo(w.w); f[7] = bfhi(w.w); }
DI u32x4 pack8f(const float* f) { u32x4 w; w.x = pk2(f[0], f[1]); w.y = pk2(f[2], f[3]); w.z = pk2(f[4], f[5]); w.w = pk2(f[6], f[7]); return w; }
DI void nsa_post_phase(Frame& F, int j, int gw, int NGW) {
    const int lane = F.lane;
    const bf16_t* P = (const bf16_t*)(F.ws + WS_PBUF);
    bf16_t* Q = (bf16_t*)(F.ws + WS_QA); bf16_t* QR = Q + (size_t)T * DM; bf16_t* KS = QR + (size_t)T * DM; bf16_t* KW = KS + (size_t)T * 256;
    const float* ct = (const float*)(F.ws + WS_ROPE); const float* st = ct + SEQ * 32;
    const int c = lane & 3, hd = lane >> 2;
    float gq1[8], gq2[8], gk1[8], gk2[8];
    {
        const float* gq = F.in[7] + j * 64;
#pragma unroll
        for (int i = 0; i < 8; ++i) { gq1[i] = gq[8 * c + i]; gq2[i] = gq[32 + 8 * c + i]; }
        const float* gk = F.in[8] + (j * 3 + ((lane >> 4) & 1) + 1) * 64;
#pragma unroll
        for (int i = 0; i < 8; ++i) { gk1[i] = gk[8 * c + i]; gk2[i] = gk[32 + 8 * c + i]; }
    }
#pragma unroll 2
    for (int row = gw; row < T; row += NGW) {
        const bf16_t* pr = P + (size_t)row * NSA_INP;
        const int t = row & (SEQ - 1);
        float cs[8], sn[8];
        { const f32x4 c0 = *(const f32x4*)(ct + t * 32 + 8 * c), c1 = *(const f32x4*)(ct + t * 32 + 8 * c + 4), s0 = *(const f32x4*)(st + t * 32 + 8 * c), s1 = *(const f32x4*)(st + t * 32 + 8 * c + 4);
#pragma unroll
          for (int i = 0; i < 4; ++i) { cs[i] = c0[i]; cs[4 + i] = c1[i]; sn[i] = s0[i]; sn[4 + i] = s1[i]; } }
        {
            float a[8], b[8];
            unpack8(*(const u32x4*)(pr + hd * 64 + 8 * c), a); unpack8(*(const u32x4*)(pr + hd * 64 + 32 + 8 * c), b);
            float ss = 0.f;
#pragma unroll
            for (int i = 0; i < 8; ++i) ss += a[i] * a[i] + b[i] * b[i];
            ss += shx(ss, 1); ss += shx(ss, 2);
            const float rstd = 1.0f / sqrtf(ss * (1.0f / 64.0f) + RMS_EPS);
            float o1[8], o2[8];
#pragma unroll
            for (int i = 0; i < 8; ++i) { const float x1 = a[i] * rstd * gq1[i], x2 = b[i] * rstd * gq2[i]; o1[i] = x1 * NSA_QS; o2[i] = x2 * NSA_QS; }
            *(u32x4*)(Q + (size_t)row * DM + hd * 64 + 8 * c) = pack8f(o1); *(u32x4*)(Q + (size_t)row * DM + hd * 64 + 32 + 8 * c) = pack8f(o2);
        }
        if (lane < 32) {
            const int grp = hd & 3; const bool win = lane >= 16;
            const bf16_t* kp = pr + (win ? PC_KW : PC_KS) + grp * 64;
            float a[8], b[8];
            unpack8(*(const u32x4*)(kp + 8 * c), a); unpack8(*(const u32x4*)(kp + 32 + 8 * c), b);
            float ss = 0.f;
#pragma unroll
            for (int i = 0; i < 8; ++i) ss += a[i] * a[i] + b[i] * b[i];
            ss += shx(ss, 1); ss += shx(ss, 2);
            const float rstd = 1.0f / sqrtf(ss * (1.0f / 64.0f) + RMS_EPS);
            float r1[8], r2[8];
#pragma unroll
            for (int i = 0; i < 8; ++i) { const float x1 = a[i] * rstd * gk1[i], x2 = b[i] * rstd * gk2[i]; r1[i] = x1 * cs[i] - x2 * sn[i]; r2[i] = x2 * cs[i] + x1 * sn[i]; }
            bf16_t* ko = (win ? KW : KS) + (size_t)row * 256 + grp * 64;
            *(u32x4*)(ko + 8 * c) = pack8f(r1); *(u32x4*)(ko + 32 + 8 * c) = pack8f(r2);
        }
    }
}

DI void cmp2_phase(Frame& F, int j) {
    const int gw = F.bid * NWAVES + F.wave, NGW = F.G * NWAVES, lane = F.lane;
    const bf16_t* HID = (const bf16_t*)(F.ws + WS_HID);
    bf16_t* KC = (bf16_t*)(F.ws + WS_KCMP); bf16_t* VC = (bf16_t*)(F.ws + WS_VCMP);
    const float gk = F.in[8][(j * 3 + 0) * 64 + lane];
    float w2r[128]; int curkv = -1;
#pragma unroll 1
    for (int row = gw; row < 2 * 16 * NCMPP; row += NGW) {
        const int n = row & 511, g = (row >> 9) & 3, b = (row >> 11) & 3, kv = row >> 13;
        if (kv != curkv) { const float* w2 = F.in[6] + (size_t)(j * 2 + kv) * 128 * 64 + lane;
#pragma unroll
            for (int h = 0; h < 128; ++h) w2r[h] = w2[(size_t)h * 64];
            curkv = kv; }
        const u32x4* hr = (const u32x4*)(HID + (size_t)row * 128);
        u32x4 hq[16];
#pragma unroll
        for (int h8 = 0; h8 < 16; ++h8) hq[h8] = hr[h8];
        float a0 = 0.f, a1 = 0.f, a2 = 0.f, a3 = 0.f;
#pragma unroll
        for (int h8 = 0; h8 < 16; ++h8) { float hv[8]; unpack8(hq[h8], hv);
            a0 += hv[0] * w2r[8 * h8] + hv[4] * w2r[8 * h8 + 4]; a1 += hv[1] * w2r[8 * h8 + 1] + hv[5] * w2r[8 * h8 + 5];
            a2 += hv[2] * w2r[8 * h8 + 2] + hv[6] * w2r[8 * h8 + 6]; a3 += hv[3] * w2r[8 * h8 + 3] + hv[7] * w2r[8 * h8 + 7]; }
        const float acc = (a0 + a1) + (a2 + a3);
        float o = acc;
        if (kv == 0) { const float ss = wave_sum(acc * acc); o = acc * (1.0f / sqrtf(ss * (1.0f / 64.0f) + RMS_EPS)) * gk; }
        if (n >= NCMP) o = 0.f;
        bf16_t* dst = (kv ? VC : KC) + (((size_t)b * NCMPP + n) * 4 + g) * 64 + lane;
        *dst = (bf16_t)f2bf(o);
    }
}

DI void mla_post_phase(Frame& F, int j) {
    const int gw = F.bid * NWAVES + F.wave, NGW = F.G * NWAVES, lane = F.lane;
    const bf16_t* C1 = (const bf16_t*)(F.ws + WS_PBUF); const bf16_t* Qraw = C1 + (size_t)T * MLA_INP; const bf16_t* KVraw = Qraw + (size_t)T * 1536;
    bf16_t* Qf = (bf16_t*)(F.ws + WS_QA); bf16_t* Kf = Qf + (size_t)T * 1536; bf16_t* Vf = Kf + (size_t)T * 1536;
    const float* ct = (const float*)(F.ws + WS_ROPE); const float* st = ct + SEQ * 32;
    const int h = lane >> 3, c8 = lane & 7;
    float gqn[16], gkn[16], gqr1[4], gqr2[4], gkr1[4], gkr2[4];
#pragma unroll
    for (int i = 0; i < 16; ++i) { gqn[i] = F.in[15][j * 128 + 16 * c8 + i]; gkn[i] = F.in[17][j * 128 + 16 * c8 + i]; }
#pragma unroll
    for (int i = 0; i < 4; ++i) { gqr1[i] = F.in[16][j * 64 + 4 * c8 + i]; gqr2[i] = F.in[16][j * 64 + 32 + 4 * c8 + i]; gkr1[i] = F.in[18][j * 64 + 4 * c8 + i]; gkr2[i] = F.in[18][j * 64 + 32 + 4 * c8 + i]; }
#pragma unroll 2
    for (int row = gw; row < T; row += NGW) {
        const int t = row & (SEQ - 1);
        const bf16_t* c1 = C1 + (size_t)row * MLA_INP;
        float rq, rkv;
        { const u32x2 a = *(const u32x2*)(c1 + 4 * lane), b = *(const u32x2*)(c1 + 256 + 4 * lane);
          float sq = bflo(a.x) * bflo(a.x) + bfhi(a.x) * bfhi(a.x) + bflo(a.y) * bflo(a.y) + bfhi(a.y) * bfhi(a.y);
          float sk = bflo(b.x) * bflo(b.x) + bfhi(b.x) * bfhi(b.x) + bflo(b.y) * bflo(b.y) + bfhi(b.y) * bfhi(b.y);
          sq = wave_sum(sq); sk = wave_sum(sk);
          rq = 1.0f / sqrtf(sq * (1.0f / 256.0f) + RMS_EPS); rkv = 1.0f / sqrtf(sk * (1.0f / 256.0f) + RMS_EPS); }
        float cs[4], sn[4];
        { const f32x4 c0 = *(const f32x4*)(ct + t * 32 + 4 * c8), s0 = *(const f32x4*)(st + t * 32 + 4 * c8);
#pragma unroll
          for (int i = 0; i < 4; ++i) { cs[i] = c0[i]; sn[i] = s0[i]; } }
        {
            const bf16_t* qp = Qraw + (size_t)row * 1536 + h * 192;
            float a[16]; unpack8(*(const u32x4*)(qp + 16 * c8), a); unpack8(*(const u32x4*)(qp + 16 * c8 + 8), a + 8);
            float ss = 0.f;
#pragma unroll
            for (int i = 0; i < 16; ++i) { a[i] *= rq; ss += a[i] * a[i]; }
            ss += shx(ss, 1); ss += shx(ss, 2); ss += shx(ss, 4);
            const float rs = 1.0f / sqrtf(ss * (1.0f / 128.0f) + RMS_EPS) * MLA_QS;
#pragma unroll
            for (int i = 0; i < 16; ++i) a[i] = a[i] * rs * gqn[i];
            bf16_t* qo = Qf + (size_t)row * 1536 + h * 192;
            *(u32x4*)(qo + 16 * c8) = pack8f(a); *(u32x4*)(qo + 16 * c8 + 8) = pack8f(a + 8);
            const u32x2 r1 = *(const u32x2*)(qp + 128 + 4 * c8), r2 = *(const u32x2*)(qp + 160 + 4 * c8);
            float x1[4] = {bflo(r1.x) * rq, bfhi(r1.x) * rq, bflo(r1.y) * rq, bfhi(r1.y) * rq}, x2[4] = {bflo(r2.x) * rq, bfhi(r2.x) * rq, bflo(r2.y) * rq, bfhi(r2.y) * rq};
            float s2 = 0.f;
#pragma unroll
            for (int i = 0; i < 4; ++i) s2 += x1[i] * x1[i] + x2[i] * x2[i];
            s2 += shx(s2, 1); s2 += shx(s2, 2); s2 += shx(s2, 4);
            const float rr = 1.0f / sqrtf(s2 * (1.0f / 64.0f) + RMS_EPS) * MLA_QS;
            float o1[4], o2[4];
#pragma unroll
            for (int i = 0; i < 4; ++i) { const float y1 = x1[i] * rr * gqr1[i], y2 = x2[i] * rr * gqr2[i]; o1[i] = y1 * cs[i] - y2 * sn[i]; o2[i] = y2 * cs[i] + y1 * sn[i]; }
            u32x2 w1, w2; w1.x = pk2(o1[0], o1[1]); w1.y = pk2(o1[2], o1[3]); w2.x = pk2(o2[0], o2[1]); w2.y = pk2(o2[2], o2[3]);
            *(u32x2*)(qo + 128 + 4 * c8) = w1; *(u32x2*)(qo + 160 + 4 * c8) = w2;
        }
        u32x2 kr1, kr2;
        {
            const u32x2 r1 = *(const u32x2*)(c1 + 512 + 4 * c8), r2 = *(const u32x2*)(c1 + 544 + 4 * c8);
            float x1[4] = {bflo(r1.x), bfhi(r1.x), bflo(r1.y), bfhi(r1.y)}, x2[4] = {bflo(r2.x), bfhi(r2.x), bflo(r2.y), bfhi(r2.y)};
            float s2 = 0.f;
#pragma unroll
            for (int i = 0; i < 4; ++i) s2 += x1[i] * x1[i] + x2[i] * x2[i];
            s2 += shx(s2, 1); s2 += shx(s2, 2); s2 += shx(s2, 4);
            const float rr = 1.0f / sqrtf(s2 * (1.0f / 64.0f) + RMS_EPS);
            float o1[4], o2[4];
#pragma unroll
            for (int i = 0; i < 4; ++i) { const float y1 = x1[i] * rr * gkr1[i], y2 = x2[i] * rr * gkr2[i]; o1[i] = y1 * cs[i] - y2 * sn[i]; o2[i] = y2 * cs[i] + y1 * sn[i]; }
            kr1.x = pk2(o1[0], o1[1]); kr1.y = pk2(o1[2], o1[3]); kr2.x = pk2(o2[0], o2[1]); kr2.y = pk2(o2[2], o2[3]);
        }
        {
            const bf16_t* kp = KVraw + (size_t)row * 2048 + h * 256;
            float a[16]; unpack8(*(const u32x4*)(kp + 16 * c8), a); unpack8(*(const u32x4*)(kp + 16 * c8 + 8), a + 8);
            float ss = 0.f;
#pragma unroll
            for (int i = 0; i < 16; ++i) { a[i] *= rkv; ss += a[i] * a[i]; }
            ss += shx(ss, 1); ss += shx(ss, 2); ss += shx(ss, 4);
            const float rs = 1.0f / sqrtf(ss * (1.0f / 128.0f) + RMS_EPS);
#pragma unroll
            for (int i = 0; i < 16; ++i) a[i] = a[i] * rs * gkn[i];
            bf16_t* ko = Kf + (size_t)row * 1536 + h * 192;
            *(u32x4*)(ko + 16 * c8) = pack8f(a); *(u32x4*)(ko + 16 * c8 + 8) = pack8f(a + 8);
            *(u32x2*)(ko + 128 + 4 * c8) = kr1; *(u32x2*)(ko + 160 + 4 * c8) = kr2;
            float v[16]; unpack8(*(const u32x4*)(kp + 128 + 16 * c8), v); unpack8(*(const u32x4*)(kp + 128 + 16 * c8 + 8), v + 8);
#pragma unroll
            for (int i = 0; i < 16; ++i) v[i] *= rkv;
            bf16_t* vo = Vf + (size_t)row * DM + h * 128;
            *(u32x4*)(vo + 16 * c8) = pack8f(v); *(u32x4*)(vo + 16 * c8 + 8) = pack8f(v + 8);
        }
    }
}
DI f32x16 zero16() { const f32x16 z = {0.f, 0.f, 0.f, 0.f, 0.f, 0.f, 0.f, 0.f, 0.f, 0.f, 0.f, 0.f, 0.f, 0.f, 0.f, 0.f}; return z; }
DI float partner32(float v, int hi) { auto rr = __builtin_amdgcn_permlane32_swap(__float_as_uint(v), __float_as_uint(v), false, false); return hi ? __uint_as_float(rr[0]) : __uint_as_float(rr[1]); }
#define MFMA32(a, b, c) __builtin_amdgcn_mfma_f32_32x32x16_bf16((a), (b), (c), 0, 0, 0)
constexpr size_t WS_LLIST = WS_ROUTE + 1 * MiB, WS_HIST = WS_ROUTE + 2 * MiB, WS_TOT = WS_ROUTE + 3 * MiB;
constexpr size_t WS_RWH = WS_RW, WS_RWL = WS_RW + 1 * MiB;
DI void router_phase(Frame& F, int L, const bf16_t* x, bf16_t* h2, bool commit) {
    LAS float* lg = (LAS float*)F.lds;
    LAS float* rs = (LAS float*)(F.lds + 60 * 1024);
    LAS int* lcnt = (LAS int*)(F.lds + 62 * 1024);
    const int tid = F.tid, lane = F.lane, wave = F.wave, r32 = lane & 31, hi = lane >> 5;
    const bf16_t* wh = (const bf16_t*)(F.ws + WS_RWH) + (size_t)L * 96 * DM; const bf16_t* wl = (const bf16_t*)(F.ws + WS_RWL) + (size_t)L * 96 * DM;
    int* llist = (int*)(F.ws + WS_LLIST); int* hist = (int*)(F.ws + WS_HIST); float* wts = (float*)(F.ws + WS_ROUTE);
    for (int unit = F.bid; unit < T / 128; unit += F.G) {
        const int tok0 = unit * 128;
        if (tid < 64) lcnt[tid] = 0;
        {
            const int rg = wave & 3, kh = wave >> 2;
            f32x16 acc[3]; acc[0] = zero16(); acc[1] = zero16(); acc[2] = zero16();
            float ss = 0.f;
            const char* xb = (const char*)(x + (size_t)(tok0 + 32 * rg + (lane >> 2)) * XLD + 512 * kh) + (lane & 3) * 16;
            LAS unsigned char* stg = F.lds + 131072 + wave * 2048;
            const int wofs = (lane >> 2) * 64 + (((lane & 3) + (lane >> 4)) & 3) * 16;
            const int ra = r32 * 64 + ((hi + (r32 >> 2)) & 3) * 16, rb = r32 * 64 + ((2 + hi + (r32 >> 2)) & 3) * 16;
            const bf16_t* whp = wh + ((size_t)(32 * kh) * 3 * 64 + lane) * 8;
            u32x4 xbuf[2][2];
#pragma unroll
            for (int i = 0; i < 2; ++i) { xbuf[i][0] = *(const GAS u32x4*)(xb + i * 64); xbuf[i][1] = *(const GAS u32x4*)(xb + (size_t)16 * XLD * 2 + i * 64); }
#pragma unroll 1
            for (int sb = 0; sb < 8; ++sb) {
                u32x4 xf[4]; bf16x8 ah[4][3];
#pragma unroll
                for (int i = 0; i < 4; ++i)
#pragma unroll
                    for (int t = 0; t < 3; ++t) ah[i][t] = *(const GAS bf16x8*)(whp + (size_t)((4 * sb + i) * 3 + t) * 512);
                __builtin_amdgcn_sched_barrier(0);
#pragma unroll
                for (int i = 0; i < 2; ++i) { *(LAS u32x4*)(stg + wofs) = xbuf[i][0]; *(LAS u32x4*)(stg + wofs + 1024) = xbuf[i][1];
                    xf[2 * i] = *(const LAS u32x4*)(stg + ra); xf[2 * i + 1] = *(const LAS u32x4*)(stg + rb); }
                __builtin_amdgcn_sched_barrier(0);
#pragma unroll
                for (int i = 0; i < 4; ++i) {
                    const u32x4 xw = xf[i];
                    ss += (bflo(xw.x) * bflo(xw.x) + bfhi(xw.x) * bfhi(xw.x)) + (bflo(xw.y) * bflo(xw.y) + bfhi(xw.y) * bfhi(xw.y))
                        + (bflo(xw.z) * bflo(xw.z) + bfhi(xw.z) * bfhi(xw.z)) + (bflo(xw.w) * bflo(xw.w) + bfhi(xw.w) * bfhi(xw.w));
                    const bf16x8 bh = __builtin_bit_cast(bf16x8, xw);
#pragma unroll
                    for (int t = 0; t < 3; ++t) acc[t] = MFMA32(ah[i][t], bh, acc[t]);
                    if (i == 0) {
                        __builtin_amdgcn_sched_barrier(0);
                        if (sb < 7) {
#pragma unroll
                            for (int q = 0; q < 2; ++q) { xbuf[q][0] = *(const GAS u32x4*)(xb + (2 * (sb + 1) + q) * 64); xbuf[q][1] = *(const GAS u32x4*)(xb + (size_t)16 * XLD * 2 + (2 * (sb + 1) + q) * 64); } }
                        __builtin_amdgcn_sched_barrier(0); }
                }
            }
            LAS float* part = (LAS float*)(F.lds + 64 * 1024) + (rg * 64 + lane) * 49;
            if (kh == 1) {
#pragma unroll
                for (int t = 0; t < 3; ++t)
#pragma unroll
                    for (int r = 0; r < 16; ++r) part[t * 16 + r] = acc[t][r];
                part[48] = ss;
            }
            __syncthreads();
            if (kh == 0) {
#pragma unroll
                for (int t = 0; t < 3; ++t)
#pragma unroll
                    for (int r = 0; r < 16; ++r) acc[t][r] += part[t * 16 + r];
                ss += part[48];
                ss += partner32(ss, hi);
                const float rstd = 1.0f / sqrtf(ss * (1.0f / DM) + RMS_EPS);
                const int r32b = opq(lane) & 31;
                if (hi == 0) rs[32 * rg + r32b] = rstd;
                LAS float* lrow = lg + (32 * rg + r32b) * 100;
#pragma unroll
                for (int t = 0; t < 3; ++t)
#pragma unroll
                    for (int g4 = 0; g4 < 4; ++g4) { f32x4 v; v[0] = acc[t][4 * g4] * rstd; v[1] = acc[t][4 * g4 + 1] * rstd; v[2] = acc[t][4 * g4 + 2] * rstd; v[3] = acc[t][4 * g4 + 3] * rstd;
                        *(LAS f32x4*)(lrow + 32 * t + 8 * g4 + 4 * hi) = v; }
            }
        }
        __syncthreads();
        if (tid < 128) {
            const LAS float* l = lg + tid * 100;
            float gl[8];
#pragma unroll
            for (int i = 0; i < 8; ++i) gl[i] = l[i] + F.in[21][L * 8 + i];
            float gmax = gl[0]; int grp = 0;
#pragma unroll
            for (int i = 1; i < 8; ++i) { if (gl[i] > gmax) { gmax = gl[i]; grp = i; } }
            float gsum = 0.f;
#pragma unroll
            for (int i = 0; i < 8; ++i) gsum += __expf(gl[i] - gmax);
            const float gw_ = 1.0f / gsum;
            const LAS float* el = l + 8 + grp * 8; const float* eb = F.in[23] + L * 64 + grp * 8;
            float ev[8];
#pragma unroll
            for (int i = 0; i < 8; ++i) ev[i] = el[i] + eb[i];
            float b1 = ev[0]; int i1 = 0;
#pragma unroll
            for (int i = 1; i < 8; ++i) { if (ev[i] > b1) { b1 = ev[i]; i1 = i; } }
            float b2 = -3.0e38f; int i2 = 0;
#pragma unroll
            for (int i = 0; i < 8; ++i) { if (i != i1 && ev[i] > b2) { b2 = ev[i]; i2 = i; } }
            const float e2 = __expf(b2 - b1);
            const float w1 = gw_ / (1.0f + e2), w2 = gw_ * e2 / (1.0f + e2);
            const int tok = tok0 + tid; const int ex1 = grp * 8 + i1, ex2 = grp * 8 + i2;
            if (commit) { const int k1 = __hip_atomic_fetch_add(lcnt + ex1, 1, __ATOMIC_RELAXED, __HIP_MEMORY_SCOPE_WORKGROUP), k2 = __hip_atomic_fetch_add(lcnt + ex2, 1, __ATOMIC_RELAXED, __HIP_MEMORY_SCOPE_WORKGROUP);
                llist[2 * tok] = ex1 | (k1 << 8); llist[2 * tok + 1] = ex2 | (k2 << 8);
                wts[2 * tok] = w1; wts[2 * tok + 1] = w2; }
        }
        __syncthreads();
        if (commit && tid < 64) hist[unit * 64 + tid] = lcnt[tid];
        {
            const float* g = F.in[2] + L * DM;
            f32x4 gv[4];
#pragma unroll
            for (int j = 0; j < 4; ++j) gv[j] = *(const f32x4*)(g + 4 * lane + 256 * j);
#pragma unroll 1
            for (int r = 0; r < 16; r += 4) {
                f32x4 v[4][4];
#pragma unroll
                for (int q = 0; q < 4; ++q) { const u32x2* xr2 = (const u32x2*)(x + (size_t)(tok0 + 16 * wave + r + q) * XLD) + lane;
#pragma unroll
                    for (int j = 0; j < 4; ++j) { const u32x2 a = xr2[64 * j]; v[q][j][0] = bflo(a.x); v[q][j][1] = bfhi(a.x); v[q][j][2] = bflo(a.y); v[q][j][3] = bfhi(a.y); } }
#pragma unroll
                for (int q = 0; q < 4; ++q) { const int row = 16 * wave + r + q; const float rstd = rs[row];
                    u32x2* ho = (u32x2*)(h2 + (size_t)(tok0 + row) * DM) + lane;
#pragma unroll
                    for (int j = 0; j < 4; ++j) { u32x2 o; o.x = pk2(v[q][j][0] * rstd * gv[j][0], v[q][j][1] * rstd * gv[j][1]); o.y = pk2(v[q][j][2] * rstd * gv[j][2], v[q][j][3] * rstd * gv[j][3]); ho[64 * j] = o; } }
            }
        }
        __syncthreads();
    }
}
DI void moe_scatter_phase(Frame& F) {
    LAS int* ps = (LAS int*)F.lds;
    const int tid = F.tid;
    const int* llist = (const int*)(F.ws + WS_LLIST); const int* hist = (const int*)(F.ws + WS_HIST); int* rowlist = (int*)(F.ws + WS_ROWLIST); int* tot = (int*)(F.ws + WS_TOT);
    float* roww = (float*)(F.ws + WS_ROWW); const float* wts = (const float*)(F.ws + WS_ROUTE);
    for (int unit = F.bid; unit < T / 128; unit += F.G) {
        __syncthreads();
        { const int e = tid & 63, part = tid >> 6; int s = 0, t = 0;
          for (int u = part * 32; u < part * 32 + 32; ++u) { const int h = hist[u * 64 + e]; t += h; if (u < unit) s += h; }
          ps[part * 64 + e] = s; ps[512 + part * 64 + e] = t; }
        __syncthreads();
        if (tid < 64) { int s = 0, t = 0;
#pragma unroll
            for (int p = 0; p < 8; ++p) { s += ps[p * 64 + tid]; t += ps[512 + p * 64 + tid]; }
            ps[1024 + tid] = s; if (unit == 0) tot[tid] = t; }
        __syncthreads();
        if (tid < 256) { const int a = 2 * (unit * 128) + tid; const int v = llist[a]; const int e = v & 255, rk = v >> 8;
            const size_t pos = (size_t)e * T + ps[1024 + e] + rk; rowlist[pos] = a; roww[pos] = wts[a]; }
    }
}

struct KSrc { const bf16_t* p; const bf16_t* p2; };
template <int DQK> DI void dma_k(KSrc ks, int pitch, LAS unsigned char* dst, int wave, int lane) {
    const int key = 8 * wave + (lane >> 3), chunk = ((lane & 7) - (key >> 1)) & 7;
#pragma unroll
    for (int g = 0; g < DQK / 64; ++g) {
        if (DQK == 192 && g == 2) glds16(ks.p2 + (size_t)key * 64 + chunk * 8, dst + g * 8192 + wave * 1024);
        else glds16(ks.p + (size_t)key * pitch + g * 64 + chunk * 8, dst + g * 8192 + wave * 1024); }
}
template <int DV> DI void dma_v(const bf16_t* vbase, int pitch, LAS unsigned char* dst, int wave, int lane) {
#pragma unroll
    for (int c = 0; c < DV / 64; ++c) { const int blk = wave + 8 * c, d0 = blk >> 2, ks = blk & 3;
        glds16(vbase + (size_t)(16 * ks + (lane >> 2)) * pitch + d0 * 32 + (lane & 3) * 8, dst + blk * 1024); }
}
DI int crow(int r, int hi) { return (r & 3) + 8 * (r >> 2) + 4 * hi; }
#ifndef ATT_VAR
#define ATT_VAR 0
#endif
#define NEG_INF_F (-__builtin_inff())
template <int DQK> DI void qk_tile(f32x16& p0, f32x16& p1, const LAS unsigned char* Kb, const bf16x8* qf, int r32, int hi, int var = 0, const f32x16* cinit = nullptr) {
    if (var & 4) { const float c = 0.01f * r32; for (int r = 0; r < 16; ++r) { p0[r] = c; p1[r] = c; } return; }
    const unsigned kbase = (unsigned)(size_t)Kb + r32 * 128; unsigned kbi[4];
#pragma unroll
    for (int i = 0; i < 4; ++i) kbi[i] = kbase + (((2 * i + hi + (r32 >> 1)) & 7) << 4);
    const f32x16 z = {0.f, 0.f, 0.f, 0.f, 0.f, 0.f, 0.f, 0.f, 0.f, 0.f, 0.f, 0.f, 0.f, 0.f, 0.f, 0.f};
    if (cinit) { p0 = *cinit; p1 = *cinit; } else { p0 = z; p1 = z; }
#pragma unroll
    for (int g = 0; g < DQK / 64; ++g) {
        bf16x8 k0[4], k1[4];
#pragma unroll
        for (int i = 0; i < 4; ++i) {
            asm volatile("ds_read_b128 %0, %1 offset:%c2" : "=&v"(k0[i]) : "v"(kbi[i]), "i"(g * 8192) : "memory");
            asm volatile("ds_read_b128 %0, %1 offset:%c2" : "=&v"(k1[i]) : "v"(kbi[i]), "i"(g * 8192 + 4096) : "memory"); }
        asm volatile("s_waitcnt lgkmcnt(0)" ::: "memory"); __builtin_amdgcn_sched_barrier(0);
#pragma unroll
        for (int i = 0; i < 4; ++i) { p0 = MFMA32(k0[i], qf[4 * g + i], p0); p1 = MFMA32(k1[i], qf[4 * g + i], p1); }
    }
}
DI float rowmax32(const f32x16& p0, const f32x16& p1) {
    float a0 = fmaxf(p0[0], p1[0]), a1 = fmaxf(p0[1], p1[1]), a2 = fmaxf(p0[2], p1[2]), a3 = fmaxf(p0[3], p1[3]);
#pragma unroll
    for (int r = 4; r < 16; r += 4) { a0 = fmaxf(a0, fmaxf(p0[r], p1[r])); a1 = fmaxf(a1, fmaxf(p0[r + 1], p1[r + 1])); a2 = fmaxf(a2, fmaxf(p0[r + 2], p1[r + 2])); a3 = fmaxf(a3, fmaxf(p0[r + 3], p1[r + 3])); }
    const float a = fmaxf(fmaxf(a0, a1), fmaxf(a2, a3));
    auto rr = __builtin_amdgcn_permlane32_swap(__float_as_uint(a), __float_as_uint(a), false, false);
    return fmaxf(__uint_as_float(rr[0]), __uint_as_float(rr[1]));
}
DI s16x4 vtr(const LAS unsigned char* p) { return __builtin_bit_cast(s16x4, __builtin_amdgcn_ds_read_tr16_b64_v4i16((LAS v4i16_t*)p)); }
template <int DV, bool OT = false> DI void pv_tile(f32x16* o, unsigned vb_addr, const u32x4* pw, int lane, int hi, int var = 0) {
    if (var & 1) { asm volatile("" :: "v"(pw[0]), "v"(pw[1]), "v"(pw[2]), "v"(pw[3])); return; }
    const unsigned vb = vb_addr + ((lane >> 4) & 1) * 32 + (lane & 3) * 8 + (4 * hi + ((lane & 15) >> 2)) * 64;
#pragma unroll
    for (int d0 = 0; d0 < DV / 32; ++d0) {
        s16x4 lo[4], hh[4];
#pragma unroll
        for (int ks = 0; ks < 4; ++ks) {
            asm volatile("ds_read_b64_tr_b16 %0, %1 offset:%c2" : "=&v"(lo[ks]) : "v"(vb), "i"(d0 * 4096 + ks * 1024) : "memory");
            asm volatile("ds_read_b64_tr_b16 %0, %1 offset:%c2" : "=&v"(hh[ks]) : "v"(vb), "i"(d0 * 4096 + ks * 1024 + 512) : "memory"); }
        asm volatile("s_waitcnt lgkmcnt(0)" ::: "memory"); __builtin_amdgcn_sched_barrier(0);
#pragma unroll
        for (int ks = 0; ks < 4; ++ks) { const bf16x8 vf = {lo[ks][0], lo[ks][1], lo[ks][2], lo[ks][3], hh[ks][0], hh[ks][1], hh[ks][2], hh[ks][3]};
            if (OT) o[d0] = MFMA32(vf, __builtin_bit_cast(bf16x8, pw[ks]), o[d0]); else o[d0] = MFMA32(__builtin_bit_cast(bf16x8, pw[ks]), vf, o[d0]); }
    }
}
DI void pack_p(u32x4* pw, const f32x16& p0, const f32x16& p1) {
#pragma unroll
    for (int i = 0; i < 4; ++i) { pw[0][i] = pk2(p0[2 * i], p0[2 * i + 1]); pw[1][i] = pk2(p0[8 + 2 * i], p0[8 + 2 * i + 1]); pw[2][i] = pk2(p1[2 * i], p1[2 * i + 1]); pw[3][i] = pk2(p1[8 + 2 * i], p1[8 + 2 * i + 1]); }
}
template <int ND> DI void scale_rows(f32x16* o, float fac, LAS float* wsf, int r32, int hi) {
    if (hi == 0) wsf[r32] = fac;
    LDS_WAIT();
#pragma unroll
    for (int g4 = 0; g4 < 4; ++g4) { const f32x4 f = *(const LAS f32x4*)(wsf + 8 * g4 + 4 * hi);
#pragma unroll
        for (int d0 = 0; d0 < ND; ++d0)
#pragma unroll
            for (int i = 0; i < 4; ++i) o[d0][4 * g4 + i] *= f[i]; }
    LDS_WAIT();
}
template <int ND> DI void axpy_rows(f32x16* acc, const f32x16* o, float fac, LAS float* wsf, int r32, int hi) {
    if (hi == 0) wsf[r32] = fac;
    LDS_WAIT();
#pragma unroll
    for (int g4 = 0; g4 < 4; ++g4) { const f32x4 f = *(const LAS f32x4*)(wsf + 8 * g4 + 4 * hi);
#pragma unroll
        for (int d0 = 0; d0 < ND; ++d0)
#pragma unroll
            for (int i = 0; i < 4; ++i) acc[d0][4 * g4 + i] += f[i] * o[d0][4 * g4 + i]; }
    LDS_WAIT();
}
template <int ND, bool FIRST> DI void axpy_rows_lds(LAS float* accw, const f32x16* o, float fac, LAS float* wsf, int r32, int hi) {
    if (hi == 0) wsf[r32] = fac;
    LDS_WAIT();
#pragma unroll
    for (int g4 = 0; g4 < 4; ++g4) { const f32x4 f = *(const LAS f32x4*)(wsf + 8 * g4 + 4 * hi);
#pragma unroll
        for (int d0 = 0; d0 < ND; ++d0)
#pragma unroll
            for (int i = 0; i < 4; ++i) { const int idx = (d0 * 16 + 4 * g4 + i) * 64; float v = f[i] * o[d0][4 * g4 + i]; if (!FIRST) v += accw[idx]; accw[idx] = v; } }
    LDS_WAIT();
}
template <int DV, bool OT = false> DI void softmax_pv(f32x16& p0, f32x16& p1, f32x16* o, float& m, float& l, unsigned Vb, LAS float* wsf, int lane, int r32, int hi, bool lane_on = true, int var = 0) {
    const float mt = lane_on ? rowmax32(p0, p1) : NEG_INF_F;
    const bool grow = mt > m + 8.0f;
    if (__any(grow)) { const float mn = grow ? mt : m; const float alpha = fast_exp2(m - mn); l *= alpha; m = mn;
        if (OT) {
#pragma unroll
            for (int d = 0; d < DV / 32; ++d)
#pragma unroll
                for (int r = 0; r < 16; ++r) o[d][r] *= alpha;
        } else scale_rows<DV / 32>(o, alpha, wsf, r32, hi); }
    const float msub = lane_on ? m : __builtin_inff();
    float s0 = 0.f, s1 = 0.f, s2 = 0.f, s3 = 0.f;
#pragma unroll
    for (int r = 0; r < 16; ++r) { if (var & 2) { p0[r] = p0[r] - msub; p1[r] = p1[r] - msub; } else { p0[r] = fast_exp2(p0[r] - msub); p1[r] = fast_exp2(p1[r] - msub); } }
#pragma unroll
    for (int r = 0; r < 16; r += 4) { s0 += p0[r] + p1[r]; s1 += p0[r + 1] + p1[r + 1]; s2 += p0[r + 2] + p1[r + 2]; s3 += p0[r + 3] + p1[r + 3]; }
    l += (s0 + s1) + (s2 + s3);
    u32x4 pw[4]; pack_p(pw, p0, p1);
    pv_tile<DV, OT>(o, Vb, pw, lane, hi, var);
}
DI float max3a(float a, float b, float c) { float d; asm volatile("v_max3_f32 %0, %1, %2, %3" : "=v"(d) : "v"(a), "v"(b), "v"(c)); return d; }
DI float max2a(float a, float b) { float d; asm volatile("v_max_f32 %0, %1, %2" : "=v"(d) : "v"(a), "v"(b)); return d; }
DI float rowmax32a(const f32x16& p0, const f32x16& p1) {
    __builtin_amdgcn_sched_barrier(0);
    asm volatile("s_nop 7\n\ts_nop 7\n\ts_nop 7" ::: "memory");
    float a[4];
#pragma unroll
    for (int c = 0; c < 4; ++c) { float x = max3a(p0[c], p1[c], p0[c + 4]); x = max3a(x, p1[c + 4], p0[c + 8]); x = max3a(x, p1[c + 8], p0[c + 12]); a[c] = max2a(x, p1[c + 12]); }
    const float t = max2a(max3a(a[0], a[1], a[2]), a[3]);
    auto rr = __builtin_amdgcn_permlane32_swap(__float_as_uint(t), __float_as_uint(t), false, false);
    return max2a(__uint_as_float(rr[0]), __uint_as_float(rr[1]));
}
DI f32x16 splat16(float v) { const f32x16 z = {v, v, v, v, v, v, v, v, v, v, v, v, v, v, v, v}; return z; }
template <int DV> DI void softmax_pv_c(f32x16& p0, f32x16& p1, f32x16* o, float& m, float& l, f32x16& nm, bool& st, unsigned Vb, int lane, int hi, int var = 0) {
    __builtin_amdgcn_s_setprio(1);
    const float mt = rowmax32a(p0, p1);
    const bool fin = mt > -1e30f;
    const bool grow = (mt > 8.0f) || (!st && fin);
    st = st || fin;
    if (__any(grow)) { const float d = grow ? mt : 0.f; const float alpha = fast_exp2(-d); l *= alpha; m += d; nm = splat16(-m);
#pragma unroll
        for (int dd = 0; dd < DV / 32; ++dd)
#pragma unroll
            for (int r = 0; r < 16; ++r) o[dd][r] *= alpha;
#pragma unroll
        for (int r = 0; r < 16; ++r) { p0[r] -= d; p1[r] -= d; } }
    float s0 = 0.f, s1 = 0.f, s2 = 0.f, s3 = 0.f;
#pragma unroll
    for (int r = 0; r < 16; ++r) { p0[r] = fast_exp2(p0[r]); p1[r] = fast_exp2(p1[r]); }
#pragma unroll
    for (int r = 0; r < 16; r += 4) { s0 += p0[r] + p1[r]; s1 += p0[r + 1] + p1[r + 1]; s2 += p0[r + 2] + p1[r + 2]; s3 += p0[r + 3] + p1[r + 3]; }
    l += (s0 + s1) + (s2 + s3);
    u32x4 pw[4]; pack_p(pw, p0, p1);
    __builtin_amdgcn_s_setprio(0);
    pv_tile<DV, true>(o, Vb, pw, lane, hi, var);
}
template <int N> DI void wait_bar() { asm volatile("s_waitcnt vmcnt(%0) lgkmcnt(0)\n\ts_barrier" :: "n"(N) : "memory"); }
template <int DQK, int DV, class KS, class VS, class Body>
DI void tile_pipeline(int n, LAS unsigned char* lds, int kb0, int vb0, int kpitch, int vpitch, int wave, int lane, KS ksrc, VS vsrc, Body body) {
    constexpr int KSZ = DQK * 128, VSZ = DV * 128, IPT = DQK / 64 + DV / 64;
    int c = 0, n1 = 1, n2 = 2;
    if (n > 0) { dma_k<DQK>(ksrc(0), kpitch, lds + kb0, wave, lane); if (DV) dma_v<DV ? DV : 64>(vsrc(0), vpitch, lds + vb0, wave, lane); }
    if (n > 1) { dma_k<DQK>(ksrc(1), kpitch, lds + kb0 + KSZ, wave, lane); if (DV) dma_v<DV ? DV : 64>(vsrc(1), vpitch, lds + vb0 + VSZ, wave, lane); }
#pragma unroll 1
    for (int j = 0; j < n; ++j) {
        if (j + 1 < n) wait_bar<IPT>(); else wait_bar<0>();
        if (j + 2 < n) { dma_k<DQK>(ksrc(j + 2), kpitch, lds + kb0 + n2 * KSZ, wave, lane); if (DV) dma_v<DV ? DV : 64>(vsrc(j + 2), vpitch, lds + vb0 + n2 * VSZ, wave, lane); }
        body(j, (const LAS unsigned char*)(lds + kb0 + c * KSZ), (unsigned)(vb0 + c * VSZ));
        const int t = c; c = n1; n1 = n2; n2 = t;
    }
    wait_bar<0>();
}
template <int N> DI void wait_bar_sel(int naux) { if (naux == 8) wait_bar<N + 8>(); else if (naux == 4) wait_bar<N + 4>(); else wait_bar<N>(); }
template <int DQK, int DV, class KS, class VS, class Body, class Aux>
DI void tile_pipeline_aux(int n, LAS unsigned char* lds, int kb0, int vb0, int kpitch, int vpitch, int wave, int lane, KS ksrc, VS vsrc, Body body, Aux aux) {
    constexpr int KSZ = DQK * 128, VSZ = DV * 128, IPT = DQK / 64 + DV / 64;
    int c = 0, n1 = 1, n2 = 2, naux = 0;
    if (n > 0) { dma_k<DQK>(ksrc(0), kpitch, lds + kb0, wave, lane); dma_v<DV>(vsrc(0), vpitch, lds + vb0, wave, lane); }
    if (n > 1) { dma_k<DQK>(ksrc(1), kpitch, lds + kb0 + KSZ, wave, lane); dma_v<DV>(vsrc(1), vpitch, lds + vb0 + VSZ, wave, lane); }
#pragma unroll 1
    for (int j = 0; j < n; ++j) {
        if (j + 1 < n) wait_bar_sel<IPT>(naux); else wait_bar_sel<0>(naux);
        naux = aux(j, n);
        if (j + 2 < n) { dma_k<DQK>(ksrc(j + 2), kpitch, lds + kb0 + n2 * KSZ, wave, lane); dma_v<DV>(vsrc(j + 2), vpitch, lds + vb0 + n2 * VSZ, wave, lane); }
        body(j, (const LAS unsigned char*)(lds + kb0 + c * KSZ), (unsigned)(vb0 + c * VSZ));
        const int t = c; c = n1; n1 = n2; n2 = t;
    }
    wait_bar<0>();
}
constexpr int A_KB = 0, A_VB = 24576, A_WS = 49152, A_IMP = 57344, A_OST = 57344, A_ACC = 90112;
static_assert(A_ACC + 65536 <= LDS_MISC, "NSA attention LDS map");
DI unsigned okey(float f) { const unsigned u = __float_as_uint(f); return (u >> 31) ? ~u : (u | 0x80000000u); }

DI float quad_sum(float v) {
    v += __builtin_bit_cast(float, __builtin_amdgcn_mov_dpp(__builtin_bit_cast(int, v), 0xB1, 0xF, 0xF, true));
    v += __builtin_bit_cast(float, __builtin_amdgcn_mov_dpp(__builtin_bit_cast(int, v), 0x4E, 0xF, 0xF, true));
    return v;
}
template <int VAR> DI void nsa_attn_unit(Frame& F, int b, int g, int bi) {
    const int lane = F.lane, wave = F.wave, r32 = lane & 31, hi = lane >> 5;
    LAS unsigned char* lds = F.lds;
    LAS float* wsf = (LAS float*)(lds + A_WS + wave * 1024);
    LAS unsigned long long* wmask = (LAS unsigned long long*)(lds + A_WS + wave * 1024 + 256);
    LAS float* imp = (LAS float*)(lds + A_IMP) + wave * 8 * 128;
    f32x16 oacc[2]; oacc[0] = zero16(); oacc[1] = zero16();
    const int qq = r32 >> 2, hd = r32 & 3, qloc = 8 * wave + qq;
    const int tpos = 64 * bi + qloc;
    const bf16_t* P = (const bf16_t*)(F.ws + WS_PBUF);
    const bf16_t* Q = (const bf16_t*)(F.ws + WS_QA); const bf16_t* QR = Q + (size_t)T * DM; const bf16_t* KS = QR + (size_t)T * DM; const bf16_t* KW = KS + (size_t)T * 256;
    const bf16_t* KC = (const bf16_t*)(F.ws + WS_KCMP); const bf16_t* VC = (const bf16_t*)(F.ws + WS_VCMP);
#define NSA_GATE(br) ({ const int lo_ = opq(F.lane); const int r32o = lo_ & 31; ((const float*)(F.ws + WS_GATES))[((size_t)b * SEQ + 64 * bi + 8 * wave + (r32o >> 2)) * 48 + 16 * (br) + 4 * g + (r32o & 3)]; })
    unsigned long long wor_lo = 0ull, wor_hi = 0ull;
    {
        const int lane = opq(F.lane);
        bf16x8 qf[4];
        { const int r32o = lane & 31, hio = lane >> 5; const size_t toko = (size_t)b * SEQ + 64 * bi + 8 * wave + (r32o >> 2);
#pragma unroll
        for (int d0 = 0; d0 < 4; ++d0) qf[d0] = *(const bf16x8*)(Q + toko * DM + (4 * g + (r32o & 3)) * 64 + 16 * d0 + 8 * hio); }
        const int nmax = (4 * bi + 3 < NCMP) ? 4 * bi + 3 : NCMP; const int nct = (nmax + 63) >> 6;
        const int nv = tpos >= 31 ? ((tpos - 31) >> 4) + 1 : 0;
        const bf16_t* kc0 = KC + ((size_t)b * NCMPP * 4 + g) * 64; const bf16_t* vc0 = VC + ((size_t)b * NCMPP * 4 + g) * 64;
        float m = -1e30f, l = 0.f;
        tile_pipeline<64, 0>(nct, lds, A_KB, A_VB, 256, 256, wave, lane,
            [&](int t) { return KSrc{kc0 + (size_t)t * 64 * 256, nullptr}; }, [&](int t) { return vc0; },
            [&](int ct, const LAS unsigned char* Kb, unsigned Vb) {
                f32x16 p0, p1; qk_tile<64>(p0, p1, Kb, qf, r32, hi);
                if (__any(64 * ct + 63 >= nv)) {
#pragma unroll
                    for (int r = 0; r < 16; ++r) { const int n = 64 * ct + crow(r, hi); if (n >= nv) p0[r] = NEG_INF_F; if (n + 32 >= nv) p1[r] = NEG_INF_F; }
                }
                const float mt = rowmax32(p0, p1), mn = fmaxf(m, mt);
                float s0 = 0.f, s1 = 0.f, s2 = 0.f, s3 = 0.f;
#pragma unroll
                for (int r = 0; r < 16; r += 4) { s0 += fast_exp2(p0[r] - mn) + fast_exp2(p1[r] - mn); s1 += fast_exp2(p0[r + 1] - mn) + fast_exp2(p1[r + 1] - mn);
                    s2 += fast_exp2(p0[r + 2] - mn) + fast_exp2(p1[r + 2] - mn); s3 += fast_exp2(p0[r + 3] - mn) + fast_exp2(p1[r + 3] - mn); }
                l = l * fast_exp2(m - mn) + ((s0 + s1) + (s2 + s3)); m = mn;
            });
        const float ltot = l + partner32(l, hi);
        const float inv = ltot > 0.f ? 1.0f / ltot : 0.f;
        f32x16 oc[2]; oc[0] = zero16(); oc[1] = zero16();
        float cprev = 0.f;
        tile_pipeline<64, 64>(nct, lds, A_KB, A_VB, 256, 256, wave, lane,
            [&](int t) { return KSrc{kc0 + (size_t)t * 64 * 256, nullptr}; }, [&](int t) { return vc0 + (size_t)t * 64 * 256; },
            [&](int ct, const LAS unsigned char* Kb, unsigned Vb) {
                f32x16 p0, p1; qk_tile<64>(p0, p1, Kb, qf, r32, hi);
                if (__any(64 * ct + 63 >= nv)) {
#pragma unroll
                    for (int r = 0; r < 16; ++r) { const int n = 64 * ct + crow(r, hi);
                        p0[r] = (n < nv) ? fast_exp2(p0[r] - m) * inv : 0.f; p1[r] = (n + 32 < nv) ? fast_exp2(p1[r] - m) * inv : 0.f; }
                } else {
#pragma unroll
                    for (int r = 0; r < 16; ++r) { p0[r] = fast_exp2(p0[r] - m) * inv; p1[r] = fast_exp2(p1[r] - m) * inv; }
                }
                float mainv[8], e3v[8];
#pragma unroll
                for (int k = 0; k < 8; ++k) { const f32x16& src = (k < 4) ? p0 : p1; const int bs = 4 * (k & 3);
                    float mv = 2.0f * (src[bs] + src[bs + 1] + src[bs + 2]) + src[bs + 3], ev = src[bs + 3];
                    mv = quad_sum(mv); ev = quad_sum(ev);
                    mainv[k] = mv; e3v[k] = ev; }
                float pe[8];
#pragma unroll
                for (int k = 0; k < 8; ++k) pe[k] = partner32(e3v[k], hi);
#pragma unroll
                for (int k = 0; k < 8; ++k) { const float carry = hi ? pe[k] : (k > 0 ? pe[k > 0 ? k - 1 : 0] : cprev);
                    if (hd == 0) imp[qq * 128 + 16 * ct + 2 * k + hi] = mainv[k] + carry; }
                cprev = pe[7];
                u32x4 pw[4]; pack_p(pw, p0, p1);
                pv_tile<64, true>(oc, Vb, pw, lane, hi);
            });
        { float gate_c = NSA_GATE(0);
#ifdef DBG_NO_C
          gate_c = 0.f;
#endif
#pragma unroll
          for (int d = 0; d < 2; ++d)
#pragma unroll
              for (int r = 0; r < 16; ++r) oacc[d][r] = gate_c * oc[d][r]; }
        {
            unsigned k0[8], k1[8], prefix[8]; int cnt16[8] = {0, 0, 0, 0, 0, 0, 0, 0};
            const int j0 = lane, j1 = lane + 64;
            const bool f0 = (j0 == 0) || (j0 == bi) || (j0 == bi - 1), f1 = (j1 == bi) || (j1 == bi - 1);
#pragma unroll
            for (int q8 = 0; q8 < 8; ++q8) { const LAS float* ir = imp + q8 * 128;
                const float s0 = f0 ? 1.0e4f : (j0 <= bi ? ir[j0] : -1.0f), s1 = f1 ? 1.0e4f : (j1 <= bi ? ir[j1 <= bi ? j1 : 0] : -1.0f);
                k0[q8] = okey(s0); k1[q8] = okey(s1); prefix[q8] = 0u; }
            if (bi >= 16) {
#pragma unroll
                for (int q8 = 0; q8 < 8; ++q8) prefix[q8] = 0x80000000u;
                if (bi >= 64) {
#pragma unroll 1
                    for (int bit = 30; bit >= 0; --bit) {
                        int open = 0;
#pragma unroll
                        for (int q8 = 0; q8 < 8; ++q8) { const unsigned trial = prefix[q8] | (1u << bit);
                            const int c = __popcll(__ballot(k0[q8] >= trial)) + __popcll(__ballot(k1[q8] >= trial));
                            if (c >= 16) { prefix[q8] = trial; cnt16[q8] = c; }
                            open |= cnt16[q8] ^ 16; }
                        if (open == 0) break;
                    }
                } else {
#pragma unroll 1
                    for (int bit = 30; bit >= 0; --bit) {
                        int open = 0;
#pragma unroll
                        for (int q8 = 0; q8 < 8; ++q8) { const unsigned trial = prefix[q8] | (1u << bit);
                            const int c = __popcll(__ballot(k0[q8] >= trial));
                            if (c >= 16) { prefix[q8] = trial; cnt16[q8] = c; }
                            open |= cnt16[q8] ^ 16; }
                        if (open == 0) break;
                    }
                }
            } else {
#pragma unroll 1
                for (int bit = 31; bit >= 0; --bit) {
#pragma unroll
                    for (int q8 = 0; q8 < 8; ++q8) { const unsigned trial = prefix[q8] | (1u << bit);
                        const int c = __popcll(__ballot(k0[q8] >= trial)) + __popcll(__ballot(k1[q8] >= trial));
                        if (c >= 16) prefix[q8] = trial; }
                }
            }
            const unsigned long long lt = (1ull << lane) - 1ull;
#pragma unroll
            for (int q8 = 0; q8 < 8; ++q8) {
                const unsigned pf = prefix[q8];
                const unsigned long long gt0 = __ballot(k0[q8] > pf), gt1 = __ballot(k1[q8] > pf), eq0 = __ballot(k0[q8] == pf), eq1 = __ballot(k1[q8] == pf);
                const int need = 16 - (__popcll(gt0) + __popcll(gt1));
                const int rk0 = __popcll(eq0 & lt), rk1 = __popcll(eq0) + __popcll(eq1 & lt);
                const bool sel0 = (k0[q8] > pf) || (k0[q8] == pf && rk0 < need), sel1 = (k1[q8] > pf) || (k1[q8] == pf && rk1 < need);
                const unsigned long long m0 = __ballot(sel0), m1 = __ballot(sel1);
                if (lane == 0) { wmask[2 * q8] = m0; wmask[2 * q8 + 1] = m1; }
                wor_lo |= m0; wor_hi |= m1;
            }
        }
        LDS_WAIT();
    }
    bf16x8 qr[4];
    { const int lo_ = opq(F.lane); const int r32o = lo_ & 31, hio = lo_ >> 5; const int tq = 64 * bi + 8 * wave + (r32o >> 2); const size_t toko = (size_t)b * SEQ + tq;
      const float* ctq = (const float*)(F.ws + WS_ROPE) + tq * 32 + 8 * hio; const float* stq = ctq + SEQ * 32;
#pragma unroll
      for (int p2 = 0; p2 < 2; ++p2) {
          const u32x4 w1 = *(const u32x4*)(Q + toko * DM + (4 * g + (r32o & 3)) * 64 + 16 * p2 + 8 * hio), w2 = *(const u32x4*)(Q + toko * DM + (4 * g + (r32o & 3)) * 64 + 32 + 16 * p2 + 8 * hio);
          const f32x4 ca = *(const f32x4*)(ctq + 16 * p2), cb = *(const f32x4*)(ctq + 16 * p2 + 4), sa = *(const f32x4*)(stq + 16 * p2), sb = *(const f32x4*)(stq + 16 * p2 + 4);
          float x1[8], x2[8], r1[8], r2[8];
          unpack8(w1, x1); unpack8(w2, x2);
#pragma unroll
          for (int i = 0; i < 8; ++i) { const float cc = i < 4 ? ca[i & 3] : cb[i & 3], ss = i < 4 ? sa[i & 3] : sb[i & 3]; r1[i] = x1[i] * cc - x2[i] * ss; r2[i] = x2[i] * cc + x1[i] * ss; }
          qr[p2] = __builtin_bit_cast(bf16x8, pack8f(r1)); qr[p2 + 2] = __builtin_bit_cast(bf16x8, pack8f(r2)); } }
    {
        const int lane = opq(F.lane);
        f32x16 os[2]; os[0] = zero16(); os[1] = zero16();
        float m = 0.f, l = 0.f; f32x16 nm = zero16(); bool st = false;
        const bf16_t* k0p = KS + (size_t)b * SEQ * 256 + g * 64; const bf16_t* v0p = P + (size_t)b * SEQ * NSA_INP + PC_VS + g * 64;
        int cst = 0;
        tile_pipeline_aux<64, 64>((VAR & 16) ? 0 : bi + 1, lds, A_KB, A_VB, 256, NSA_INP, wave, lane,
            [&](int t) { return KSrc{k0p + (size_t)t * 64 * 256, nullptr}; }, [&](int t) { return v0p + (size_t)t * 64 * NSA_INP; },
            [&](int j, const LAS unsigned char* Kb, unsigned Vb) {
                const bool wact = (((j < 64) ? (wor_lo >> j) : (wor_hi >> (j - 64))) & 1ull) != 0ull;
                if (wact) {
                    const bool sel = ((wmask[2 * qq + (j >> 6)] >> (j & 63)) & 1ull) != 0ull;
                    f32x16 ci;
#pragma unroll
                    for (int r = 0; r < 16; ++r) ci[r] = sel ? nm[r] : NEG_INF_F;
                    f32x16 p0, p1; qk_tile<64>(p0, p1, Kb, qr, r32, hi, VAR, &ci);
                    if (j == bi) {
#pragma unroll
                        for (int r = 0; r < 16; ++r) { const int kl = crow(r, hi); if (kl > qloc) p0[r] = NEG_INF_F; if (kl + 32 > qloc) p1[r] = NEG_INF_F; }
                    }
                    softmax_pv_c<64>(p0, p1, os, m, l, nm, st, Vb, lane, hi, VAR);
                }
            },
            [&](int j, int n) -> int {
                LAS unsigned char* cscr = lds + A_ACC + wave * 8192;
                if (cst == 2) { const ConvItem ci_ = conv_item2(F.in, F.ws, F.cv_L, F.cv_it); conv_finish(ci_, cscr, opq(F.lane)); LDS_WAIT(); F.cv_it += F.G * NWAVES; cst = 0; return 4; }
                if (cst == 1) { cst = 2; return 0; }
                if ((j & 7) == 0 && j + 2 < n && F.cv_it < F.cv_end) { const ConvItem ci_ = conv_item2(F.in, F.ws, F.cv_L, F.cv_it); conv_issue(ci_, cscr, opq(F.lane)); cst = 1; return 8; }
                return 0;
            });
        const float ltot = l + partner32(l, hi);
        { float gate_s = NSA_GATE(1);
#ifdef DBG_NO_S
          gate_s = 0.f;
#endif
          const float fac = ltot > 0.f ? gate_s / ltot : 0.f;
#pragma unroll
          for (int d = 0; d < 2; ++d)
#pragma unroll
              for (int r = 0; r < 16; ++r) oacc[d][r] += fac * os[d][r]; }
    }
    {
        const int lane = opq(F.lane);
        f32x16 ow[2]; ow[0] = zero16(); ow[1] = zero16();
        float m = 0.f, l = 0.f; f32x16 nm = zero16(); bool st = false;
        const int jt0 = bi >= 8 ? bi - 8 : 0;
        const bf16_t* k0p = KW + (size_t)b * SEQ * 256 + g * 64; const bf16_t* v0p = P + (size_t)b * SEQ * NSA_INP + PC_VW + g * 64;
        tile_pipeline<64, 64>((VAR & 16) ? 0 : bi - jt0 + 1, lds, A_KB, A_VB, 256, NSA_INP, wave, lane,
            [&](int t) { return KSrc{k0p + (size_t)(jt0 + t) * 64 * 256, nullptr}; }, [&](int t) { return v0p + (size_t)(jt0 + t) * 64 * NSA_INP; },
            [&](int t, const LAS unsigned char* Kb, unsigned Vb) {
                const int jt = jt0 + t;
                f32x16 p0, p1; qk_tile<64>(p0, p1, Kb, qr, r32, hi, VAR, &nm);
                if (jt == bi - 8) {
#pragma unroll
                    for (int r = 0; r < 16; ++r) { const int kl = crow(r, hi); if (kl <= qloc) p0[r] = NEG_INF_F; if (kl + 32 <= qloc) p1[r] = NEG_INF_F; }
                } else if (jt == bi) {
#pragma unroll
                    for (int r = 0; r < 16; ++r) { const int kl = crow(r, hi); if (kl > qloc) p0[r] = NEG_INF_F; if (kl + 32 > qloc) p1[r] = NEG_INF_F; }
                }
                softmax_pv_c<64>(p0, p1, ow, m, l, nm, st, Vb, lane, hi, VAR);
            });
        const float ltot = l + partner32(l, hi);
        { float gate_w = NSA_GATE(2);
#ifdef DBG_NO_W
          gate_w = 0.f;
#endif
          const float fac = ltot > 0.f ? gate_w / ltot : 0.f;
#pragma unroll
          for (int d = 0; d < 2; ++d)
#pragma unroll
              for (int r = 0; r < 16; ++r) oacc[d][r] += fac * ow[d][r]; }
    }
    {
        const int lane = opq(F.lane);
        LAS bf16_t* stg = (LAS bf16_t*)(lds + A_OST) + wave * 2048;
#pragma unroll
        for (int d0 = 0; d0 < 2; ++d0)
#pragma unroll
            for (int g4 = 0; g4 < 4; ++g4) { u32x2 w; w.x = pk2(oacc[d0][4 * g4], oacc[d0][4 * g4 + 1]); w.y = pk2(oacc[d0][4 * g4 + 2], oacc[d0][4 * g4 + 3]);
                *(LAS u32x2*)(stg + r32 * 64 + 32 * d0 + 8 * g4 + 4 * hi) = w; }
        LDS_WAIT();
        bf16_t* O = (bf16_t*)(F.ws + (VAR >= 8 ? WS_H : WS_O));
#pragma unroll
        for (int i = 0; i < 4; ++i) { const int row = i * 8 + (lane >> 3), ch = lane & 7;
            const u32x4 v = *(const LAS u32x4*)(stg + row * 64 + ch * 8);
            *(u32x4*)(O + ((size_t)b * SEQ + 64 * bi + 8 * wave + (row >> 2)) * DM + (4 * g + (row & 3)) * 64 + ch * 8) = v; }
        LDS_WAIT();
    }
#undef NSA_GATE
}


template <bool MLA>
DI void narrow_unit(Frame& F, const bf16_t* Hn, const bf16_t* Wn, int pm, int j) {
    const int tid = opq(F.tid), lane = tid & 63, wid = tid >> 6, hi = lane >> 5, tk = lane & 31;
    __syncthreads();
    {
        const int a = lane >> 3, rho = 8 * wid + (lane & 7);
        int wrow = rho;
        if (MLA) { const int n = rho >> 5, rem = rho & 31; wrow = 8 * (rem >> 2) + 4 * n + (rem & 3); }
        const char* src = (const char*)Wn + (size_t)wrow * (DM * 2) + a * 16;
        LAS unsigned char* dst = F.lds + (a * 64 + rho) * 16;
        u32x4 v[16];
#pragma unroll
        for (int i = 0; i < 16; ++i) v[i] = *(const GAS u32x4*)(src + i * 128);
#pragma unroll
        for (int i = 0; i < 16; ++i) *(LAS u32x4*)(dst + i * 8192) = v[i];
    }
    const int row = pm * 256 + 32 * wid + tk;
    const char* hp = (const char*)Hn + (size_t)(pm * 256 + 32 * wid + (lane >> 2)) * (DM * 2) + (lane & 3) * 16;
    LAS unsigned char* stg = F.lds + 131072 + wid * 2048;
    const int wofs = (lane >> 2) * 64 + (((lane & 3) + (lane >> 4)) & 3) * 16;
    const int rofs0 = tk * 64 + ((hi + (tk >> 2)) & 3) * 16, rofs1 = tk * 64 + ((2 + hi + (tk >> 2)) & 3) * 16;
    const LAS unsigned char* wp = F.lds + hi * 1024 + tk * 16;
    f32x16 acc0 = splat16(0.f), acc1 = splat16(0.f);
    u32x4 hbuf[8][2];
#pragma unroll
    for (int d = 0; d < 8; ++d) { hbuf[d][0] = *(const GAS u32x4*)(hp + d * 64); hbuf[d][1] = *(const GAS u32x4*)(hp + 16 * DM * 2 + d * 64); }
    LDS_WAIT(); __syncthreads();
    bf16x8 fb[2][2], fa[2][4];
#define NU_STAGE(Kt_) do { *(LAS u32x4*)(stg + wofs) = hbuf[(Kt_) & 7][0]; *(LAS u32x4*)(stg + wofs + 1024) = hbuf[(Kt_) & 7][1]; \
        __builtin_amdgcn_sched_barrier(0);                    \
        if ((Kt_) + 8 < 32) { hbuf[(Kt_) & 7][0] = *(const GAS u32x4*)(hp + ((Kt_) + 8) * 64); hbuf[(Kt_) & 7][1] = *(const GAS u32x4*)(hp + 16 * DM * 2 + ((Kt_) + 8) * 64); } \
        __builtin_amdgcn_sched_barrier(0); \
        fb[(Kt_) & 1][0] = *(const LAS bf16x8*)(stg + rofs0); fb[(Kt_) & 1][1] = *(const LAS bf16x8*)(stg + rofs1); \
        _Pragma("unroll") for (int q = 0; q < 4; ++q) fa[(Kt_) & 1][q] = *(const LAS bf16x8*)(wp + (4 * (Kt_) + 2 * (q >> 1)) * 1024 + (q & 1) * 512); \
        __builtin_amdgcn_sched_barrier(0); } while (0)
    NU_STAGE(0);
#pragma unroll
    for (int Kt = 0; Kt < 32; ++Kt) {
        if (Kt + 1 < 32) NU_STAGE(Kt + 1);
#pragma unroll
        for (int ks = 0; ks < 2; ++ks) { acc0 = MFMA32(fa[Kt & 1][2 * ks], fb[Kt & 1][ks], acc0); acc1 = MFMA32(fa[Kt & 1][2 * ks + 1], fb[Kt & 1][ks], acc1); }
        __builtin_amdgcn_sched_barrier(0);
    }
#undef NU_STAGE
    if (!MLA) {
        float* gt = (float*)(F.ws + WS_GATES) + (size_t)row * 48 + 4 * hi;
#pragma unroll
        for (int qd = 0; qd < 6; ++qd) { f32x4 gv;
#pragma unroll
            for (int i = 0; i < 4; ++i) { const float a = qd < 4 ? acc0[4 * (qd & 3) + i] : acc1[4 * (qd & 3) + i]; const float x = __uint_as_float(pk2(a, 0.f) << 16); gv[i] = 1.0f / (1.0f + __expf(-x)); }
            *(f32x4*)(gt + 8 * qd) = gv; }
    } else {
        float ss = 0.f;
#pragma unroll
        for (int r = 0; r < 16; ++r) ss += acc0[r] * acc0[r] + acc1[r] * acc1[r];
        { auto rr = __builtin_amdgcn_permlane32_swap(__float_as_uint(ss), __float_as_uint(ss), false, false); ss = __uint_as_float(rr[0]) + __uint_as_float(rr[1]); }
        const float rs = __builtin_amdgcn_rsqf(ss * (1.0f / 64.0f) + RMS_EPS);
        const float* gkr = F.in[18] + j * 64; const float* ct = (const float*)(F.ws + WS_ROPE); const float* st = ct + SEQ * 32;
        bf16_t* kr = (bf16_t*)(F.ws + WS_HID) + (size_t)row * 64; const int t = row & (SEQ - 1);
#pragma unroll
        for (int qd = 0; qd < 4; ++qd) { const int q0 = 8 * qd + 4 * hi;
            const f32x4 g1 = *(const f32x4*)(gkr + q0), g2 = *(const f32x4*)(gkr + 32 + q0), c4 = *(const f32x4*)(ct + t * 32 + q0), s4 = *(const f32x4*)(st + t * 32 + q0);
            f32x4 a1, a2;
#pragma unroll
            for (int i = 0; i < 4; ++i) { a1[i] = acc0[4 * qd + i]; a2[i] = acc1[4 * qd + i]; }
            const f32x4 x1 = a1 * rs * g1, x2 = a2 * rs * g2;
            const f32x4 o1 = x1 * c4 - x2 * s4, o2 = x2 * c4 + x1 * s4;
            *(u32x2*)(kr + q0) = pg8::pack4(o1); *(u32x2*)(kr + 32 + q0) = pg8::pack4(o2); }
    }
}

template <int VAR> DI void nsa_attn_phase(Frame& F) {
    for (int v = F.vcu; v < 256; v += F.G) {
        const int pair = v >> 4, s = v & 15;
#pragma unroll 1
        for (int i = 0; i < 8; ++i) { const int bi = 32 * (i >> 1) + ((i & 1) ? 31 - s : s);
            nsa_attn_unit<VAR>(F, pair >> 2, pair & 3, bi); }
    }
#pragma unroll 1
    while (F.cv_it < F.cv_end) { LAS unsigned char* cscr = F.lds + A_ACC + F.wave * 8192; const ConvItem ci_ = conv_item2(F.in, F.ws, F.cv_L, F.cv_it);
        conv_issue(ci_, cscr, opq(F.lane)); asm volatile("s_waitcnt vmcnt(0)" ::: "memory"); conv_finish(ci_, cscr, opq(F.lane)); LDS_WAIT(); F.cv_it += F.G * NWAVES; }
}
constexpr int M_KB = 0, M_VB = 73728, M_WS = 122880, M_OST = 0;
static_assert(M_WS + 2048 <= LDS_MISC, "MLA attention LDS map");
DI void mla_attn_unit(Frame& F, int b, int h, int qb) {
    const int lane = F.lane, wave = F.wave, r32 = lane & 31, hi = lane >> 5;
    LAS unsigned char* lds = F.lds;
    LAS float* wsf = (LAS float*)(lds + M_WS + wave * 256);
    const bf16_t* Qf = (const bf16_t*)(F.ws + WS_QA); const bf16_t* Kn = Qf + (size_t)T * 1536; const bf16_t* Vf = Kn + (size_t)T * DM; const bf16_t* KR = (const bf16_t*)(F.ws + WS_HID);
    const int tq = 256 * qb + 32 * wave + r32;
    bf16x8 qf[12];
    { const int lo_ = opq(F.lane); const size_t toko = (size_t)b * SEQ + 256 * qb + 32 * wave + (lo_ & 31);
#pragma unroll
    for (int d0 = 0; d0 < 12; ++d0) qf[d0] = *(const bf16x8*)(Qf + toko * 1536 + h * 192 + 16 * d0 + 8 * (lo_ >> 5)); }
    f32x16 o[4]; o[0] = zero16(); o[1] = zero16(); o[2] = zero16(); o[3] = zero16();
    float m = 0.f, l = 0.f; f32x16 nm = zero16(); bool st = false;
    const int NT = 4 * qb + 4;
    const bf16_t* k0p = Kn + (size_t)b * SEQ * DM + h * 128; const bf16_t* krp = KR + (size_t)b * SEQ * 64; const bf16_t* v0p = Vf + (size_t)b * SEQ * DM + h * 128;
    const int wmin = 256 * qb + 32 * wave;
    tile_pipeline<192, 128>(NT, lds, M_KB, M_VB, DM, DM, wave, opq(F.lane),
        [&](int t) { return KSrc{k0p + (size_t)t * 64 * DM, krp + (size_t)t * 64 * 64}; }, [&](int t) { return v0p + (size_t)t * 64 * DM; },
        [&](int kt, const LAS unsigned char* Kb, unsigned Vb) {
            if (64 * kt <= wmin + 31) {
                f32x16 p0, p1; qk_tile<192>(p0, p1, Kb, qf, r32, hi, 0, &nm);
                if (64 * kt + 63 > wmin) {
                    const int lim = tq - 64 * kt;
#pragma unroll
                    for (int r = 0; r < 16; ++r) { const int kl = crow(r, hi); if (kl > lim) p0[r] = NEG_INF_F; if (kl + 32 > lim) p1[r] = NEG_INF_F; }
                }
                softmax_pv_c<128>(p0, p1, o, m, l, nm, st, Vb, lane, hi);
            }
        });
    const float ltot = l + partner32(l, hi);
    const float invl = ltot > 0.f ? 1.0f / ltot : 0.f;
    {
        const int lane = opq(F.lane);
        LAS bf16_t* stg = (LAS bf16_t*)(lds + M_OST) + wave * 4096;
#pragma unroll
        for (int d0 = 0; d0 < 4; ++d0)
#pragma unroll
            for (int g4 = 0; g4 < 4; ++g4) { u32x2 w; w.x = pk2(o[d0][4 * g4] * invl, o[d0][4 * g4 + 1] * invl); w.y = pk2(o[d0][4 * g4 + 2] * invl, o[d0][4 * g4 + 3] * invl);
                *(LAS u32x2*)(stg + r32 * 128 + 32 * d0 + 8 * g4 + 4 * hi) = w; }
        LDS_WAIT();
        bf16_t* O = (bf16_t*)(F.ws + WS_O);
#pragma unroll
        for (int i = 0; i < 8; ++i) { const int row = i * 4 + (lane >> 4), ch = lane & 15;
            const u32x4 v = *(const LAS u32x4*)(stg + row * 128 + ch * 8);
            *(u32x4*)(O + ((size_t)b * SEQ + 256 * qb + 32 * wave + row) * DM + h * 128 + ch * 8) = v; }
    }
    asm volatile("s_waitcnt lgkmcnt(0)\n\ts_barrier" ::: "memory");
}
DI void mla_attn_phase(Frame& F) {
    for (int v = F.vcu; v < 256; v += F.G) {
        const int bh = v >> 3, s = v & 7;
#pragma unroll 1
        for (int i = 0; i < 4; ++i) { const int qb = (i == 0) ? s : (i == 1) ? 15 - s : (i == 2) ? 16 + s : 31 - s;
            mla_attn_unit(F, bh >> 3, bh & 7, qb); }
    }
}
#ifndef MK_ONE_LAUNCH
#define MK_ONE_LAUNCH 1
#endif
constexpr int N_PHASES = 42;
struct Args { const float* in[27]; float* out; unsigned char* ws; int ph_lo, ph_hi; };

DI void moe_tables(Frame& F, int L, LAS int* tst, LAS int* cntl) {
    const int* cnt = (const int*)(F.ws + WS_TOT);
    __syncthreads();
    if (F.tid < NEXP) cntl[F.tid] = cnt[F.tid];
    __syncthreads();
    if (F.tid == 0) { int s = 0; for (int e = 0; e < NEXP; ++e) { tst[e] = s; s += (cntl[e] + 255) >> 8; } tst[NEXP] = s; }
    __syncthreads();
}

__global__ void __launch_bounds__(NTHREADS, 2) fwd_kernel(Args args) {
    extern __shared__ __attribute__((aligned(16))) unsigned char lds_raw[];
    Frame F;
    F.lds = (LAS unsigned char*)lds_raw; F.ws = args.ws; F.in = args.in;
    F.wave = __builtin_amdgcn_readfirstlane((int)threadIdx.x >> 6); F.lane = lane_id(); F.tid = F.wave * 64 + F.lane;
    F.G = gridDim.x; F.bid = blockIdx.x; F.vcu = (F.G % 8 == 0) ? (F.bid % 8) * (F.G / 8) + F.bid / 8 : F.bid;
    volatile LAS unsigned* MISC = (volatile LAS unsigned*)(F.lds + LDS_MISC);
    for (int u = F.tid; u < (LDS_BYTES - LDS_MISC) / 4; u += NTHREADS) MISC[u] = 0u;
    __syncthreads();
    const int lo = args.ph_lo, hi = args.ph_hi;
    unsigned* ctl = (unsigned*)(F.ws + WS_CTL);
    XcdBarrier bar; bar.bar = ctl + CW_BAR; bar.x = 0; bar.st = MISC + 8;
    if (hi - lo > 1) bar = xcd_barrier_post(ctl + CW_BAR, MISC + 8, F.tid == 0);
    LAS int* tst = (LAS int*)(F.lds + LDS_MISC + 64); LAS int* cntl = tst + 72;
    bf16_t* xres = (bf16_t*)args.out + DM;
#define Hb ((bf16_t*)(F.ws + WS_H))
#define Ob ((bf16_t*)(F.ws + WS_O))
#define Y2 ((bf16_t*)(F.ws + WS_PBUF))
#ifndef REP1
#define REP1 1
#endif
#ifndef REP2
#define REP2 1
#endif
#ifndef REP3
#define REP3 1
#endif
#ifndef REP4N
#define REP4N 1
#endif
#ifndef REP4M
#define REP4M 1
#endif
#ifndef REP7
#define REP7 1
#endif
#ifndef REP8
#define REP8 1
#endif
#ifndef REPN
#define REPN 1
#endif
#ifndef REPR
#define REPR 1
#endif
#ifndef REPS
#define REPS 1
#endif
#ifndef REP0W
#define REP0W 1
#endif
#ifndef PHMASK
#define PHMASK 0x3fff
#endif
#define PHEN(p) (((PHMASK) >> (p)) & 1)
#define IN(k) (lo <= (k) && (k) < hi)
#define SEAM(k) do { if (hi > (k) + 1) xcd_barrier(bar, F.tid == 0); } while (0)
#define PHB() do { F.lane = opq(lane_id()); F.tid = F.wave * 64 + F.lane; F.ws = opq_p(args.ws); } while (0)

#ifndef REPP
#define REPP 1
#endif
    if (PHEN(9) && IN(0)) { PHB(); for (int rep = 0; rep < REPP; ++rep) prologue_phase(F); SEAM(0); }

#pragma unroll 1
    for (int L = 0; L < DEPTH; ++L) {
        const int pb = 1 + 10 * L, j = L >> 1; const bool nsa = (L & 1) == 0;
#ifdef DBG_NO_MLA
        const bool mix_on = nsa;
#elif defined(DBG_NO_NSA)
        const bool mix_on = !nsa;
#else
        const bool mix_on = true;
#endif
#ifdef DBG_NO_MOE
        const bool moe_on = false;
#else
        const bool moe_on = true;
#endif
        if (PHEN(0) && IN(pb)) {
            PHB();
            if (L == 0) compress_bias_reduce(F);
            norm_phase(F, L == 0 ? args.in[0] : nullptr, xres, xres, (L == 0 || !moe_on) ? nullptr : Y2, args.in[1] + L * DM, Hb);
            for (int rep = 1; rep < REPN; ++rep) norm_phase(F, nullptr, xres, xres, nullptr, args.in[1] + L * DM, Hb);
            SEAM(pb);
        }
        if (PHEN(1) && mix_on && IN(pb + 1)) {
            PHB();
            pg8::DenseSched S; pg8::GemmGeo g{DM, DM, DM, 128u};
            if (nsa) { const bf16_t* Wn = (const bf16_t*)(F.ws + WS_NSA_WIN) + (size_t)j * NSA_INP * DM;
                S.init(Hb, DM, Wn, DM, F.ws + WS_PBUF, NSA_INP, 2, T, PC_GT, F.G, F.bid);
                pg8::EpiStoreBf16 E; for (int rep = 0; rep < REP1; ++rep) pg8::gemm_phase<pg8::EpiStoreBf16, pg8::DenseSched, false>(F.lds, opq(F.tid), g, S, E);
                for (int idx = F.bid; idx < 256; idx += F.G) if ((idx >> 3) < 16) narrow_unit<false>(F, Hb, Wn + (size_t)PC_GT * DM, 16 * (idx & 7) + (idx >> 3), j); }
            else { const bf16_t* Wn = (const bf16_t*)(F.ws + WS_MLA_WIN) + (size_t)j * MLA_INP * DM;
                S.init(Hb, DM, Wn, DM, F.ws + WS_PBUF, MLA_INP, 2, T, 512, F.G, F.bid);
                pg8::EpiMlaIn E{F.ws, args.in, j};
                for (int rep = 0; rep < REP1; ++rep) pg8::gemm_phase<pg8::EpiMlaIn, pg8::DenseSched, false>(F.lds, opq(F.tid), g, S, E);
                for (int idx = F.bid; idx < 256; idx += F.G) if ((idx >> 3) < 16) narrow_unit<true>(F, Hb, Wn + (size_t)512 * DM, 16 * (idx & 7) + (idx >> 3), j); }
            SEAM(pb + 1);
        }
        if (PHEN(2) && mix_on && IN(pb + 2)) {
            PHB();
            for (int rep = 0; rep < REP2; ++rep) {
            if (nsa && PHEN(10)) {
                const int ncmp = F.G >= 128 ? 64 : (F.G > 1 ? F.G / 2 : 1);
                if (F.bid < ncmp) {
                    pg8::CmpSched S{(const char*)(F.ws + WS_PBUF), (const char*)(F.ws + WS_CMP_W1T) + (size_t)j * 2 * 256 * 2048 * 2, (char*)(F.ws + WS_HID), ncmp, F.bid};
                    pg8::GemmGeo g{2048, 16 * NSA_INP, 2048, (unsigned)(NSA_INP * 2)}; pg8::EpiCmpGelu E{(const float*)(F.ws + WS_CMPB) + j * 256};
                    pg8::gemm_phase<pg8::EpiCmpGelu, pg8::CmpSched, false, true>(F.lds, opq(F.tid), g, S, E);
                }
                if (F.G == 1 || F.bid >= ncmp) { const int nb = F.G == 1 ? 1 : F.G - ncmp, b0 = F.G == 1 ? 0 : F.bid - ncmp; nsa_post_phase(F, j, b0 * NWAVES + F.wave, nb * NWAVES); }
            } else if (!nsa && PHEN(11)) {
                pg8::MlaUpSched S{(const char*)(F.ws + WS_PBUF), (const char*)(F.ws + WS_MLA_WUQ) + (size_t)j * 1536 * 256 * 2, (const char*)(F.ws + WS_MLA_WUKV) + (size_t)j * 2048 * 256 * 2, F.G, F.vcu};
                pg8::GemmGeo g{256, MLA_INP, 256, 128u};
                pg8::EpiMlaUp E{F.ws, args.in, j};
                pg8::gemm_phase<pg8::EpiMlaUp, pg8::MlaUpSched, false>(F.lds, opq(F.tid), g, S, E);
            }
            }
            SEAM(pb + 2);
        }
        if (PHEN(3) && mix_on && nsa && IN(pb + 3)) { PHB(); for (int rep = 0; rep < REP3; ++rep) cmp2_phase(F, j); SEAM(pb + 3); }
        if (PHEN(4) && mix_on && IN(pb + 4)) { PHB(); if (nsa) { if (PHEN(12)) { F.cv_it = F.bid * NWAVES + F.wave; F.cv_end = 2 * CONV_NIT; F.cv_L = L; nsa_attn_phase<0>(F);
#ifdef PRB_NSA_VAR
            nsa_attn_phase<PRB_NSA_VAR>(F);
#endif
            } } else { if (PHEN(13)) for (int rep = 0; rep < REP4M; ++rep) mla_attn_phase(F); } SEAM(pb + 4); }
        if (PHEN(5) && mix_on && IN(pb + 5)) {
            PHB();
            pg8::DenseSched S; S.init(Ob, DM, (const bf16_t*)(F.ws + (nsa ? WS_NSA_WOUT : WS_MLA_WOUT)) + (size_t)j * DM * DM, DM, xres, XLD, 2, T, DM, F.G, F.bid);
            pg8::GemmGeo g{DM, DM, DM, 128u}; pg8::EpiResidB E;
            pg8::gemm_phase<pg8::EpiResidB, pg8::DenseSched, false>(F.lds, opq(F.tid), g, S, E);
#ifdef PRB_WOUT
            { pg8::DenseSched S2; S2.init(Ob, DM, (const bf16_t*)(F.ws + (nsa ? WS_NSA_WOUT : WS_MLA_WOUT)) + (size_t)j * DM * DM, DM, F.ws + WS_PBUF, DM, 4, T, DM, F.G, F.bid);
              pg8::gemm_phase<pg8::EpiResid, pg8::DenseSched, false>(F.lds, opq(F.tid), g, S2, E); }
#endif
            SEAM(pb + 5);
        }
        if (PHEN(6) && moe_on && IN(pb + 6)) { PHB(); for (int rep = 0; rep < REPR; ++rep) router_phase(F, L, xres, Hb, rep == 0); SEAM(pb + 6); }
        if (PHEN(6) && moe_on && IN(pb + 7)) { PHB(); for (int rep = 0; rep < REPS; ++rep) moe_scatter_phase(F); SEAM(pb + 7); }
        const int IMAX = 0x7fffffff;
        if (PHEN(7) && moe_on && IN(pb + 8)) {
            PHB();
            moe_tables(F, L, tst, cntl);
            const int nt2 = 2 * tst[NEXP]; const int a_end = (hi - lo > 1) ? (nt2 / F.G) * F.G : nt2;
            pg8::MoeSched S{tst, cntl, (const int*)(F.ws + WS_ROWLIST), (const char*)Hb, (const char*)(F.ws + ((L & 1) ? WS_MOE_W1B : WS_MOE_W1)), (char*)(F.ws + WS_QA), 2, 1, F.G, F.vcu, 0, a_end, IMAX, 0};
            pg8::GemmGeo g{DM, DM, DM, 128u}; pg8::EpiSwiGLU E;
            pg8::gemm_phase<pg8::EpiSwiGLU, pg8::MoeSched, true>(F.lds, opq(F.tid), g, S, E);
            SEAM(pb + 8);
        }
        if (PHEN(8) && moe_on && IN(pb + 9)) {
            PHB();
            moe_tables(F, L, tst, cntl);
            const int nt2 = 2 * tst[NEXP]; const int a_end = (hi - lo > 1) ? (nt2 / F.G) * F.G : nt2; const int R1 = nt2 - a_end;
            if (R1 > 0) {
                pg8::MoeSched S{tst, cntl, (const int*)(F.ws + WS_ROWLIST), (const char*)Hb, (const char*)(F.ws + ((L & 1) ? WS_MOE_W1B : WS_MOE_W1)), (char*)(F.ws + WS_QA), 2, 1, F.G, F.vcu, a_end, nt2, IMAX, 0};
                pg8::GemmGeo g{DM, DM, DM, 128u}; pg8::EpiSwiGLU E;
                pg8::gemm_phase<pg8::EpiSwiGLU, pg8::MoeSched, true>(F.lds, opq(F.tid), g, S, E);
            }
            pg8::GemmGeo g{MOE_FF, MOE_FF, MOE_FF, 128u}; pg8::EpiMoeOut E{Y2};
            {
                const int n2b = 2 * a_end; const int m = (n2b + 2 * R1 + F.G - 1) / F.G; const int kk = R1 > 0 ? (m > 2 ? m - 2 : 0) : IMAX;
                pg8::MoeSched S{tst, cntl, (const int*)(F.ws + WS_ROWLIST), (const char*)(F.ws + WS_QA), (const char*)(F.ws + ((L & 1) ? WS_MOE_W2B : WS_MOE_W2)), (char*)(F.ws + WS_ROWW), 4, 2, F.G, F.vcu, 0, n2b, kk, R1};
                pg8::gemm_phase<pg8::EpiMoeOut, pg8::MoeSched, false>(F.lds, opq(F.tid), g, S, E);
            }
            if (R1 > 0) {
                xcd_barrier(bar, F.tid == 0);
                pg8::MoeSched S{tst, cntl, (const int*)(F.ws + WS_ROWLIST), (const char*)(F.ws + WS_QA), (const char*)(F.ws + ((L & 1) ? WS_MOE_W2B : WS_MOE_W2)), (char*)(F.ws + WS_ROWW), 4, 2, F.G, F.vcu, 2 * a_end, IMAX, IMAX, 0};
                pg8::gemm_phase<pg8::EpiMoeOut, pg8::MoeSched, false>(F.lds, opq(F.tid), g, S, E);
            }
            SEAM(pb + 9);
        }
    }
    if (IN(41)) { PHB();
#ifdef PRB_ROUTER
        router_phase(F, 3, xres, Hb, false);
#endif
#ifdef PRB_GEMM_WIN
        { pg8::DenseSched S; S.init(Hb, DM, (const bf16_t*)(F.ws + WS_NSA_WIN), DM, F.ws + WS_QA, NSA_INP, 2, T, NSA_INP, F.G, F.bid);
          pg8::GemmGeo g{DM, DM, DM, 128u}; pg8::EpiStoreBf16 E; pg8::gemm_phase<pg8::EpiStoreBf16, pg8::DenseSched, false>(F.lds, opq(F.tid), g, S, E); }
#endif
#ifdef PRB_GEMM_WOUT
        { pg8::DenseSched S; S.init(Ob, DM, (const bf16_t*)(F.ws + WS_NSA_WOUT), DM, F.ws + WS_QA, DM, 2, T, DM, F.G, F.bid);
          pg8::GemmGeo g{DM, DM, DM, 128u}; pg8::EpiStoreBf16 E; pg8::gemm_phase<pg8::EpiStoreBf16, pg8::DenseSched, false>(F.lds, opq(F.tid), g, S, E); }
#endif
#ifdef PRB_NSAPOST
        nsa_post_phase(F, 0, F.bid * NWAVES + F.wave, F.G * NWAVES);
#endif
#ifdef PRB_BAR
        for (int rep = 0; rep < 20; ++rep) xcd_barrier(bar, F.tid == 0);
#endif
#ifndef DBG_NO_MOE
 final_phase(F, args.out, (const bf16_t*)(F.ws + WS_PBUF));
#endif
 }
#undef IN
#undef SEAM
#undef Hb
#undef Ob
#undef Y2
}

extern "C" void kernel_launch(void* const* d_in, const int* in_sizes, int n_in, void* d_out, int out_size, void* d_ws, size_t ws_size, hipStream_t stream) {
    static int grid = 0;
    if (grid == 0) {
        if (n_in != 27 || out_size != T * DM || ws_size < WS_END) { fprintf(stderr, "kernel_launch: unexpected problem (n_in %d, out %d, ws %zu)\n", n_in, out_size, ws_size); grid = -1; return; }
        int dev = 0, cus = 0, per_cu = 0;
        if (hipGetDevice(&dev) != hipSuccess || hipDeviceGetAttribute(&cus, hipDeviceAttributeMultiprocessorCount, dev) != hipSuccess) { grid = -1; return; }
        if (hipFuncSetAttribute((const void*)fwd_kernel, hipFuncAttributeMaxDynamicSharedMemorySize, LDS_BYTES) != hipSuccess) { fprintf(stderr, "kernel_launch: hipFuncSetAttribute failed\n"); grid = -1; return; }
        if (hipOccupancyMaxActiveBlocksPerMultiprocessor(&per_cu, (const void*)fwd_kernel, NTHREADS, LDS_BYTES) != hipSuccess || per_cu < 1) { fprintf(stderr, "kernel_launch: occupancy query says %d\n", per_cu); }
        (void)hipGetLastError();
        grid = cus;
    }
    if (grid < 0) return;
    if (hipMemsetAsync((char*)d_ws + WS_CTL, 0, CTL_ZERO_BYTES, stream) != hipSuccess) return;
    Args a{};
    for (int i = 0; i < 27; ++i) a.in[i] = (const float*)d_in[i];
    a.out = (float*)d_out; a.ws = (unsigned char*)d_ws;
#if MK_ONE_LAUNCH
    a.ph_lo = 0; a.ph_hi = N_PHASES;
    hipLaunchKernelGGL(fwd_kernel, dim3(grid), dim3(NTHREADS), LDS_BYTES, stream, a);
#else
    for (int k = 0; k < N_PHASES; ++k) {
        a.ph_lo = k; a.ph_hi = k + 1;
        hipLaunchKernelGGL(fwd_kernel, dim3(grid), dim3(NTHREADS), LDS_BYTES, stream, a);
    }
#endif
}
```
